# Optimizing an MI355X kernel written in HIP

```python
import jax, jax.numpy as jnp
from jax import lax
import numpy as np

D_MODEL = 1024
BATCH = 16
SEQ = 2048
DEPTH = 1
DEC_BATCH = 8
DEC_SEQ = 2048
PAST_LEN = 128

MEM_LEN = 256
MLA_HEADS = 8
QK_NOPE_DIM = 64
QK_ROPE_DIM = 32
V_HEAD_DIM = 64
Q_LORA_RANK = 384
KV_LORA_RANK = 256
MLA_WIDTH = MLA_HEADS * V_HEAD_DIM
FNET_GROUPS = 4
FNET_GROUP_DIM = 128
FNET_WIDTH = FNET_GROUPS * FNET_GROUP_DIM
MIX_WIDTH = MLA_WIDTH + FNET_WIDTH
IN_WIDTH = Q_LORA_RANK + KV_LORA_RANK + QK_ROPE_DIM + FNET_WIDTH
XATTN_HEADS = 4
XATTN_HEAD_DIM = D_MODEL // XATTN_HEADS
D_FF = -(-8 * D_MODEL // (3 * 256)) * 256
ROPE_BASE = 10000.0
Q_BLOCK = 128
NORM_EPS = 1e-6

kernel_name = "hymba_mla_fnet_memory_encoder"


def rmsnorm(x, g):
    xf = x.astype(jnp.float32)
    y = xf * lax.rsqrt(jnp.mean(xf * xf, axis=-1, keepdims=True) + NORM_EPS)
    return (y * g.astype(jnp.float32)).astype(x.dtype)


def rope_tables(seq):
    inv = 1.0 / (ROPE_BASE ** (jnp.arange(0, QK_ROPE_DIM, 2, dtype=jnp.float32) / QK_ROPE_DIM))
    ang = jnp.arange(seq, dtype=jnp.float32)[:, None] * inv[None, :]
    return jnp.cos(ang), jnp.sin(ang)


def apply_rope(x, cos, sin):
    xf = x.astype(jnp.float32)
    half = QK_ROPE_DIM // 2
    x1, x2 = xf[..., :half], xf[..., half:]
    return jnp.concatenate([x1 * cos - x2 * sin, x2 * cos + x1 * sin], axis=-1).astype(x.dtype)


def mla(c_q, c_kv, k_rope, q_norm_g, w_uq, kv_norm_g, w_ukv):
    B, S, _ = c_q.shape
    H = MLA_HEADS
    q = jnp.einsum('bsr,rn->bsn', rmsnorm(c_q, q_norm_g), w_uq).reshape(B, S, H, QK_NOPE_DIM + QK_ROPE_DIM)
    q_nope, q_rope = q[..., :QK_NOPE_DIM], q[..., QK_NOPE_DIM:]
    kv = jnp.einsum('bsr,rn->bsn', rmsnorm(c_kv, kv_norm_g), w_ukv).reshape(B, S, H, QK_NOPE_DIM + V_HEAD_DIM)
    k_nope, v = kv[..., :QK_NOPE_DIM], kv[..., QK_NOPE_DIM:]
    cos, sin = rope_tables(S)
    q_rope = apply_rope(q_rope, cos[:, None, :], sin[:, None, :])
    k_rope = apply_rope(k_rope, cos, sin)
    nb = S // Q_BLOCK
    qn = q_nope.reshape(B, nb, Q_BLOCK, H, QK_NOPE_DIM).swapaxes(0, 1)
    qr = q_rope.reshape(B, nb, Q_BLOCK, H, QK_ROPE_DIM).swapaxes(0, 1)
    scale = (QK_NOPE_DIM + QK_ROPE_DIM) ** -0.5

    def query_block(args):
        qn_b, qr_b = args
        s = (jnp.einsum('bqhd,bkhd->bhqk', qn_b, k_nope, preferred_element_type=jnp.float32)
             + jnp.einsum('bqhr,bkr->bhqk', qr_b, k_rope, preferred_element_type=jnp.float32))
        p = jax.nn.softmax(s * scale, axis=-1).astype(v.dtype)
        return jnp.einsum('bhqk,bkhd->bqhd', p, v)

    o = lax.map(query_block, (qn, qr))
    return o.swapaxes(0, 1).reshape(B, S, H * V_HEAD_DIM)


def fourier_mix(u, w_fnet):
    B, S, _ = u.shape
    ug = u.reshape(B, S, FNET_GROUPS, FNET_GROUP_DIM).astype(jnp.float32)
    f = jnp.fft.fftn(ug, axes=(1, 3), norm='ortho').real.astype(u.dtype)
    return jnp.einsum('bsgc,gcd->bsgd', f, w_fnet).reshape(B, S, FNET_WIDTH)


def memory_xattn(h, mem, mem_norm_g, w_xq, w_xkv, w_xo):
    B, S, _ = h.shape
    M = mem.shape[1]
    m = rmsnorm(mem, mem_norm_g)
    q = jnp.einsum('bsd,dn->bsn', h, w_xq).reshape(B, S, XATTN_HEADS, XATTN_HEAD_DIM)
    kv = jnp.einsum('bmd,dn->bmn', m, w_xkv).reshape(B, M, 2, XATTN_HEADS, XATTN_HEAD_DIM)
    k, v = kv[:, :, 0], kv[:, :, 1]
    s = jnp.einsum('bqhd,bkhd->bhqk', q, k, preferred_element_type=jnp.float32) * (XATTN_HEAD_DIM ** -0.5)
    p = jax.nn.softmax(s, axis=-1).astype(v.dtype)
    o = jnp.einsum('bhqk,bkhd->bqhd', p, v).reshape(B, S, D_MODEL)
    return jnp.einsum('bsn,nd->bsd', o, w_xo)


def encoder_layer(x, mem, ln_mix_g, w_in, q_norm_g, w_uq, kv_norm_g, w_ukv, w_fnet, w_out,
                  ln_x_g, mem_norm_g, w_xq, w_xkv, w_xo, ln_ffn_g, w_gate_up, w_down):
    h = rmsnorm(x, ln_mix_g)
    z = jnp.einsum('bsd,dn->bsn', h, w_in)
    o1 = Q_LORA_RANK
    o2 = o1 + KV_LORA_RANK
    o3 = o2 + QK_ROPE_DIM
    c_q, c_kv, k_rope, u = z[..., :o1], z[..., o1:o2], z[..., o2:o3], z[..., o3:]
    y_mix = jnp.concatenate([mla(c_q, c_kv, k_rope, q_norm_g, w_uq, kv_norm_g, w_ukv),
                             fourier_mix(u, w_fnet)], axis=-1)
    x = x + jnp.einsum('bsn,nd->bsd', y_mix, w_out)
    x = x + memory_xattn(rmsnorm(x, ln_x_g), mem, mem_norm_g, w_xq, w_xkv, w_xo)
    gu = jnp.einsum('bsd,dn->bsn', rmsnorm(x, ln_ffn_g), w_gate_up)
    g, up = gu[..., :D_FF], gu[..., D_FF:]
    return x + jnp.einsum('bsf,fd->bsd', jax.nn.silu(g) * up, w_down)


def trunk(x, mem, ln_mix_g, w_in, q_norm_g, w_uq, kv_norm_g, w_ukv, w_fnet, w_out,
          ln_x_g, mem_norm_g, w_xq, w_xkv, w_xo, ln_ffn_g, w_gate_up, w_down, final_norm_g):
    for l in range(DEPTH):
        x = encoder_layer(x, mem, ln_mix_g[l], w_in[l], q_norm_g[l], w_uq[l], kv_norm_g[l], w_ukv[l],
                          w_fnet[l], w_out[l], ln_x_g[l], mem_norm_g[l], w_xq[l], w_xkv[l], w_xo[l],
                          ln_ffn_g[l], w_gate_up[l], w_down[l])
    return rmsnorm(x, final_norm_g)


def setup_inputs(seed: int = 0) -> dict:
    key = jax.random.key(seed)
    ks = jax.random.split(key, 24)
    f32 = jnp.float32

    def w(k, shape, fan_in):
        return jax.random.normal(k, shape, f32) * (fan_in ** -0.5)

    def gain(k, shape):
        return 1.0 + 0.01 * jax.random.normal(k, shape, f32)

    L = DEPTH
    return {
        "x_prompt": jax.random.normal(ks[0], (BATCH, SEQ, D_MODEL), f32),
        "x_sample": jax.random.normal(ks[1], (DEC_BATCH, DEC_SEQ, D_MODEL), f32),
        "mem_prompt": jax.random.normal(ks[2], (BATCH, MEM_LEN, D_MODEL), f32),
        "mem_sample": jax.random.normal(ks[3], (DEC_BATCH, MEM_LEN, D_MODEL), f32),
        "ln_mix_g": gain(ks[4], (L, D_MODEL)),
        "w_in": w(ks[5], (L, D_MODEL, IN_WIDTH), D_MODEL),
        "q_norm_g": gain(ks[6], (L, Q_LORA_RANK)),
        "w_uq": w(ks[7], (L, Q_LORA_RANK, MLA_HEADS * (QK_NOPE_DIM + QK_ROPE_DIM)), Q_LORA_RANK),
        "kv_norm_g": gain(ks[8], (L, KV_LORA_RANK)),
        "w_ukv": w(ks[9], (L, KV_LORA_RANK, MLA_HEADS * (QK_NOPE_DIM + V_HEAD_DIM)), KV_LORA_RANK),
        "w_fnet": w(ks[10], (L, FNET_GROUPS, FNET_GROUP_DIM, FNET_GROUP_DIM), FNET_GROUP_DIM),
        "w_out": w(ks[11], (L, MIX_WIDTH, D_MODEL), MIX_WIDTH),
        "ln_x_g": gain(ks[12], (L, D_MODEL)),
        "mem_norm_g": gain(ks[13], (L, D_MODEL)),
        "w_xq": w(ks[14], (L, D_MODEL, D_MODEL), D_MODEL),
        "w_xkv": w(ks[15], (L, D_MODEL, 2 * D_MODEL), D_MODEL),
        "w_xo": w(ks[16], (L, D_MODEL, D_MODEL), D_MODEL),
        "ln_ffn_g": gain(ks[17], (L, D_MODEL)),
        "w_gate_up": w(ks[18], (L, D_MODEL, 2 * D_FF), D_MODEL),
        "w_down": w(ks[19], (L, D_FF, D_MODEL), D_FF),
        "final_norm_g": gain(ks[20], (D_MODEL,)),
    }


def reference(x_prompt, x_sample, mem_prompt, mem_sample, ln_mix_g, w_in, q_norm_g, w_uq, kv_norm_g, w_ukv,
              w_fnet, w_out, ln_x_g, mem_norm_g, w_xq, w_xkv, w_xo, ln_ffn_g, w_gate_up, w_down, final_norm_g):
    y_prompt = trunk(x_prompt, mem_prompt, ln_mix_g, w_in, q_norm_g, w_uq, kv_norm_g, w_ukv, w_fnet, w_out,
                     ln_x_g, mem_norm_g, w_xq, w_xkv, w_xo, ln_ffn_g, w_gate_up, w_down, final_norm_g)
    y_sample = trunk(x_sample, mem_sample, ln_mix_g, w_in, q_norm_g, w_uq, kv_norm_g, w_ukv, w_fnet, w_out,
                     ln_x_g, mem_norm_g, w_xq, w_xkv, w_xo, ln_ffn_g, w_gate_up, w_down, final_norm_g)
    return (y_prompt, y_sample)
```

```cpp
#include <hip/hip_runtime.h>
#include <cstdio>
#include <cstdint>

#define LAS __attribute__((address_space(3)))
#define GAS __attribute__((address_space(1)))
typedef unsigned short bf16_t;
typedef short bf16x8 __attribute__((ext_vector_type(8)));
typedef short s16x4 __attribute__((ext_vector_type(4)));
typedef float f32x4 __attribute__((ext_vector_type(4)));
typedef float f32x2 __attribute__((ext_vector_type(2)));
typedef float f32x16 __attribute__((ext_vector_type(16)));
typedef unsigned u32x4 __attribute__((ext_vector_type(4)));
typedef unsigned u32x2 __attribute__((ext_vector_type(2)));

#ifndef DBG_STEPS
#define DBG_STEPS 0
#endif

constexpr int DM = 1024, SEQ = 2048, NB = 24, NBP = 16, T = NB * SEQ, TP = NBP * SEQ;
constexpr int MEML = 256, TMEM = NB * MEML, TMP = NBP * MEML;
constexpr int QL = 384, KVL = 256, DR = 32, FW = 512, INW = 1184;
constexpr int NH = 8, DN = 64, DVH = 64, DQK = 96;
constexpr int ZW = 768;
constexpr int DFF = 2816;
constexpr float EPS = 1e-6f;
constexpr float LOG2E = 1.4426950408889634f;
constexpr float QSCALE = 0.10206207261596577f * LOG2E;
constexpr float XSCALE = 0.0625f * LOG2E;

constexpr size_t MiB = 1u << 20;
constexpr size_t WS_CTL = 0, CTL_ZERO_BYTES = 65536;
constexpr size_t WS_WZT = 1 * MiB, WS_WFT = 3 * MiB, WS_WXKT = 5 * MiB, WS_WXVT = 7 * MiB, WS_WUQT = 9 * MiB, WS_WUKVT = 10 * MiB;
constexpr size_t WS_ROPEC = 11 * MiB, WS_ROPES = 11 * MiB + 128 * 1024;
constexpr size_t WS_DFTM = 12 * MiB, WS_WOUTT = 28 * MiB, WS_WXQT = 30 * MiB, WS_WXOT = 32 * MiB, WS_WGUT = 34 * MiB, WS_WDT = 45 * MiB;
constexpr size_t WS_R0 = 52 * MiB;
constexpr size_t WS_R1 = 148 * MiB;
constexpr size_t WS_R2 = 244 * MiB;
constexpr size_t WS_KF = WS_R2, WS_V = WS_R2 + 72 * MiB, WS_KX = WS_R2 + 120 * MiB, WS_VXT = WS_R2 + 132 * MiB, WS_H = WS_R2;
constexpr size_t WS_PS = 508 * MiB;
constexpr size_t WS_END = 511 * MiB;
constexpr size_t DO_Z = 0, DO_MN = 72 * MiB, DO_PS1 = 84 * MiB, DO_Q = 96 * MiB;
constexpr int CW_BAR = 4096;

__device__ __forceinline__ unsigned cvt_pk_bf16(float lo, float hi) { unsigned r; asm volatile("v_cvt_pk_bf16_f32 %0, %1, %2" : "=v"(r) : "v"(lo), "v"(hi)); return r; }
__device__ __forceinline__ u32x4 pack8(f32x4 a, f32x4 b) { u32x4 w; w.x = cvt_pk_bf16(a[0], a[1]); w.y = cvt_pk_bf16(a[2], a[3]); w.z = cvt_pk_bf16(b[0], b[1]); w.w = cvt_pk_bf16(b[2], b[3]); return w; }
__device__ __forceinline__ float bf2f(bf16_t v) { return __uint_as_float(((unsigned)v) << 16); }
__device__ __forceinline__ float sumsq8(f32x4 a, f32x4 b) { return (a[0] * a[0] + a[1] * a[1]) + (a[2] * a[2] + a[3] * a[3]) + (b[0] * b[0] + b[1] * b[1]) + (b[2] * b[2] + b[3] * b[3]); }
__device__ __forceinline__ float fq_sum(float v) { v += __shfl_xor(v, 16); v += __shfl_xor(v, 32); return v; }
__device__ __forceinline__ float fq_max(float v) { v = fmaxf(v, __shfl_xor(v, 16)); v = fmaxf(v, __shfl_xor(v, 32)); return v; }
__device__ __forceinline__ float wave_sum(float v) {
#pragma unroll
    for (int o = 1; o < 64; o <<= 1) v += __shfl_xor(v, o);
    return v;
}
#define LDS_WAIT() asm volatile("s_waitcnt lgkmcnt(0)" ::: "memory")
#define VM_WAIT() asm volatile("s_waitcnt vmcnt(0)" ::: "memory")

namespace pg8 {
constexpr int BM = 256, BK = 64, HALF = 128, HTB = HALF * BK * 2, STAGE_BYTES = 8 * HTB;
__host__ __device__ __forceinline__ int lds_byte(int r, int c) { const int st = (r >> 4) * 2 + (c >> 5), rr = r & 15, cc = c & 31, ob = rr * 64 + cc * 2; return st * 1024 + (ob ^ (((ob >> 9) & 1) << 5)); }
__host__ __device__ __forceinline__ void stage_rc(int b, int& R, int& C) { const int st = b / 1024, sb = b % 1024, swz = sb ^ (((sb >> 9) & 1) << 5); R = (st >> 1) * 16 + swz / 64; C = (st & 1) * 32 + (swz % 64) / 2; }
__host__ __device__ __forceinline__ int perm32(int rho) { const int n = rho >> 4, i = rho & 15; return 8 * (i >> 2) + 4 * n + (i & 3); }
struct Unit { int pm, pn, ty; const char* a; const char* b; };
}
using pg8::Unit;

enum { SK_GEN = 0, SK_P1 = 1, SK_XS = 2, SK_XPV = 3, SK_DFT = 4 };
constexpr int GRID = 256;
__device__ __forceinline__ bool tile_of(int L, int nM, int nN, int& pm, int& pn) {
    const int nwg = nM * nN; if (L >= nwg || L < 0) return false;
    const int q = nwg / 8, r = nwg % 8, xcd = L % 8, off = L / 8;
    const int wgid = (xcd < r ? xcd * (q + 1) : r * (q + 1) + (xcd - r) * q) + off;
    const int nig = 8 * nN, gid = wgid / nig, fm = gid * 8, gsz = (nM - fm) < 8 ? (nM - fm) : 8;
    pm = fm + ((wgid % nig) % gsz); pn = (wgid % nig) / gsz; return true;
}
template <int KIND, int NN, int LDA, int LDB>
struct Sched {
    const char* A; const char* B;
    __device__ __forceinline__ bool next(int i, Unit& u) const {
        const int c = (int)blockIdx.x; const int L = i * GRID + c;
        u.ty = 0;
        if constexpr (KIND == SK_GEN) {
            if (!tile_of(L, 192, NN, u.pm, u.pn)) return false;
            u.a = A + (size_t)u.pm * ((size_t)512 * LDA); u.b = B + (size_t)u.pn * ((size_t)512 * LDB); return true;
        } else if constexpr (KIND == SK_P1) {
            constexpr size_t TS = (size_t)256 * 1024 * 2; const char* ws = A; const char* dob = B;
            if (L < 768) { tile_of(L, 4, 192, u.pm, u.pn); u.ty = 0; u.a = ws + WS_WFT + u.pm * TS; u.b = ws + WS_R0 + u.pn * TS; return true; }
            if (L < 1344) { tile_of(L - 768, 192, 3, u.pm, u.pn); u.ty = 1; u.a = ws + WS_R0 + u.pm * TS; u.b = ws + WS_WZT + u.pn * TS; return true; }
            if (L < 1440) { tile_of(L - 1344, 24, 4, u.pm, u.pn); u.ty = 2; u.a = dob + DO_MN + u.pm * TS; u.b = ws + WS_WXKT + u.pn * TS; return true; }
            if (L < 1536) { tile_of(L - 1440, 4, 24, u.pm, u.pn); u.ty = 3; u.a = ws + WS_WXVT + u.pm * TS; u.b = dob + DO_MN + u.pn * TS; return true; }
            return false;
        } else if constexpr (KIND == SK_XS) {
            if (!tile_of(L, 192, 4, u.pm, u.pn)) return false;
            u.a = A + (size_t)u.pm * ((size_t)512 * 1024) + (size_t)u.pn * 512; u.b = B + (size_t)(u.pm >> 3) * ((size_t)256 * 2048) + (size_t)u.pn * 512; return true;
        } else if constexpr (KIND == SK_XPV) {
            if (!tile_of(L, 192, 4, u.pm, u.pn)) return false;
            u.a = A + (size_t)u.pm * ((size_t)512 * 1024) + (size_t)u.pn * 512; u.b = B + (size_t)((u.pm >> 3) * 4 + u.pn) * 131072; return true;
        } else {
            const int x = c & 7, j = c >> 3; if (j >= 24 || i >= 2) return false;
            const int w = j + 24 * i, bb = 3 * x + (w >> 4); u.pm = (w & 15) & 7; u.pn = (w & 15) >> 3; u.ty = bb;
            u.a = A + (size_t)u.pm * ((size_t)256 * 4096 * 2); u.b = B + ((size_t)(bb * 512 + u.pn * 256)) * 4096 * 2; return true;
        }
    }
};

enum { EK_P1 = 0, EK_Q, EK_KV, EK_DFT, EK_RES_X, EK_RES, EK_RES_NOB, EK_ROWSCALE, EK_SOFTMAX, EK_PLAIN, EK_SWIGLU };
struct Epi { unsigned char* ws; float* out; const float* xp; const float* xs; };
constexpr int LDS_SMX = 131072;

__device__ __forceinline__ float row_r16(const float* PS, int row, int fq) {
    const f32x4 p = *(const f32x4*)(PS + (size_t)row * 16 + fq * 4);
    const float tot = fq_sum((p[0] + p[1]) + (p[2] + p[3]));
    return __builtin_amdgcn_rsqf(tot * (1.0f / 1024.0f) + EPS);
}
__device__ __forceinline__ void rope8(f32x4& v0, f32x4& v1, const f32x4 cs4, const f32x4 sn4) {
    f32x4 o0, o1;
    o0[0] = v0[0] * cs4[0] - v0[1] * sn4[0]; o0[1] = v0[1] * cs4[0] + v0[0] * sn4[0];
    o0[2] = v0[2] * cs4[1] - v0[3] * sn4[1]; o0[3] = v0[3] * cs4[1] + v0[2] * sn4[1];
    o1[0] = v1[0] * cs4[2] - v1[1] * sn4[2]; o1[1] = v1[1] * cs4[2] + v1[0] * sn4[2];
    o1[2] = v1[2] * cs4[3] - v1[3] * sn4[3]; o1[3] = v1[3] * cs4[3] + v1[2] * sn4[3];
    v0 = o0; v1 = o1;
}
#define EPI_ARGS const Epi& E, f32x4 (&acc)[2][2][4][2], const Unit& u, int wr, int wc, int fr, int fq, LAS unsigned char* lds
#define EPI_ROWS for (int ai = 0; ai < 2; ++ai) _Pragma("unroll") for (int m = 0; m < 4; ++m)
#define EPI_FENCE() asm volatile("" ::: "memory")

__device__ __forceinline__ void epi_p1(EPI_ARGS) {
    const int rl0 = wr * 64 + fr, cl0 = wc * 32 + 8 * fq;
    if (u.ty == 0) {
        bf16_t* UT2 = (bf16_t*)(E.ws + WS_R1);
#pragma unroll
        EPI_ROWS { const int R = u.pm * 256 + ai * 128 + m * 16 + rl0; const int g = R >> 8, cs = (R >> 7) & 1, j = R & 127;
#pragma unroll
            for (int bj = 0; bj < 2; ++bj) { const int t = u.pn * 256 + bj * 128 + cl0; const int b = t >> 11, s = t & 2047;
                *(u32x4*)(UT2 + ((size_t)(b * 512 + g * 128 + j)) * 4096 + cs * 2048 + s) = pack8(acc[ai][bj][m][0], acc[ai][bj][m][1]); } }
    } else if (u.ty == 1) {
        bf16_t* Z = (bf16_t*)((unsigned char*)E.out + DO_Z); float* PS1 = (float*)((unsigned char*)E.out + DO_PS1); bf16_t* Kf = (bf16_t*)(E.ws + WS_KF);
        const float* ropeC = (const float*)(E.ws + WS_ROPEC); const float* ropeS = (const float*)(E.ws + WS_ROPES);
#pragma unroll
        EPI_ROWS { const int row = u.pm * 256 + ai * 128 + m * 16 + rl0;
#pragma unroll
            for (int bj = 0; bj < 2; ++bj) { const int c = u.pn * 256 + bj * 128 + cl0; f32x4 v0 = acc[ai][bj][m][0], v1 = acc[ai][bj][m][1];
                *(u32x4*)(Z + (size_t)row * ZW + c) = pack8(v0, v1);
                const float ss = fq_sum(sumsq8(v0, v1)); const int half = u.pn * 2 + bj;
                if (half < 5 && fq == 0) PS1[(size_t)row * 24 + half * 4 + wc] = ss;
                if (half == 5 && wc == 0) {
                    const int pos = row & (SEQ - 1);
                    rope8(v0, v1, *(const f32x4*)(ropeC + pos * 16 + 4 * fq), *(const f32x4*)(ropeS + pos * 16 + 4 * fq));
                    const u32x4 w = pack8(v0, v1);
#pragma unroll
                    for (int h = 0; h < NH; ++h) *(u32x4*)(Kf + (size_t)row * 768 + h * DQK + DN + 8 * fq) = w;
                } } }
    } else if (u.ty == 2) {
        bf16_t* Kx = (bf16_t*)(E.ws + WS_KX);
#pragma unroll
        EPI_ROWS { const int row = u.pm * 256 + ai * 128 + m * 16 + rl0;
#pragma unroll
            for (int bj = 0; bj < 2; ++bj) *(u32x4*)(Kx + (size_t)row * 1024 + u.pn * 256 + bj * 128 + cl0) = pack8(acc[ai][bj][m][0], acc[ai][bj][m][1]); }
    } else {
        bf16_t* VxT = (bf16_t*)(E.ws + WS_VXT);
#pragma unroll
        EPI_ROWS { const int d = ai * 128 + m * 16 + rl0;
#pragma unroll
            for (int bj = 0; bj < 2; ++bj) *(u32x4*)(VxT + ((size_t)((u.pn * 4 + u.pm) * 256 + d)) * 256 + bj * 128 + cl0) = pack8(acc[ai][bj][m][0], acc[ai][bj][m][1]); }
    }
}
__device__ __forceinline__ void epi_q(EPI_ARGS) {
    const int rl0 = wr * 64 + fr, cl0 = wc * 32 + 8 * fq;
    const float* PS1 = (const float*)((unsigned char*)E.out + DO_PS1); bf16_t* Q = (bf16_t*)((unsigned char*)E.out + DO_Q);
    const float* ropeC = (const float*)(E.ws + WS_ROPEC); const float* ropeS = (const float*)(E.ws + WS_ROPES);
#pragma unroll
    EPI_ROWS { const int row = u.pm * 256 + ai * 128 + m * 16 + rl0; const int pos = row & (SEQ - 1);
        f32x4 p = {0.f, 0.f, 0.f, 0.f}; if (fq < 3) p = *(const f32x4*)(PS1 + (size_t)row * 24 + fq * 4);
        const float r = __builtin_amdgcn_rsqf(fq_sum((p[0] + p[1]) + (p[2] + p[3])) * (1.0f / QL) + EPS);
#pragma unroll
        for (int bj = 0; bj < 2; ++bj) { const int c = u.pn * 256 + bj * 128 + cl0; const int e = c % DQK;
            f32x4 v0 = acc[ai][bj][m][0] * r, v1 = acc[ai][bj][m][1] * r;
            if (e >= DN) { const int i0 = (e - DN) >> 1; rope8(v0, v1, *(const f32x4*)(ropeC + pos * 16 + i0), *(const f32x4*)(ropeS + pos * 16 + i0)); }
            *(u32x4*)(Q + (size_t)row * 768 + c) = pack8(v0, v1); }
        EPI_FENCE(); }
}
__device__ __forceinline__ void epi_kv(EPI_ARGS) {
    const int rl0 = wr * 64 + fr, cl0 = wc * 32 + 8 * fq;
    const float* PS1 = (const float*)((unsigned char*)E.out + DO_PS1); bf16_t* Kf = (bf16_t*)(E.ws + WS_KF); bf16_t* V = (bf16_t*)(E.ws + WS_V);
#pragma unroll
    EPI_ROWS { const int row = u.pm * 256 + ai * 128 + m * 16 + rl0;
        f32x4 p = {0.f, 0.f, 0.f, 0.f}; if (fq < 2) p = *(const f32x4*)(PS1 + (size_t)row * 24 + 12 + fq * 4);
        const float r = __builtin_amdgcn_rsqf(fq_sum((p[0] + p[1]) + (p[2] + p[3])) * (1.0f / KVL) + EPS);
#pragma unroll
        for (int bj = 0; bj < 2; ++bj) { const int c = u.pn * 256 + bj * 128 + cl0; const int h = c >> 7, e = c & 127;
            const u32x4 w = pack8(acc[ai][bj][m][0] * r, acc[ai][bj][m][1] * r);
            if (e < DN) *(u32x4*)(Kf + (size_t)row * 768 + h * DQK + e) = w; else *(u32x4*)(V + (size_t)row * 512 + h * DVH + (e - DN)) = w; }
        EPI_FENCE(); }
}
template <int OMIB> __device__ __forceinline__ void epi_plain(EPI_ARGS, int rowbase, int colbase) {
    const int rl0 = wr * 64 + fr, cl0 = wc * 32 + 8 * fq;
    bf16_t* O = (bf16_t*)(E.ws + (size_t)OMIB * MiB);
#pragma unroll
    EPI_ROWS { const int row = rowbase + ai * 128 + m * 16 + rl0;
#pragma unroll
        for (int bj = 0; bj < 2; ++bj) *(u32x4*)(O + (size_t)row * 1024 + colbase + bj * 128 + cl0) = pack8(acc[ai][bj][m][0], acc[ai][bj][m][1]); }
}
template <int EKIND, int OMIB> __device__ __forceinline__ void epi_res(EPI_ARGS) {
    const int rl0 = wr * 64 + fr, cl0 = wc * 32 + 8 * fq;
    bf16_t* O = (bf16_t*)(E.ws + (size_t)OMIB * MiB); float* PS = (float*)(E.ws + WS_PS);
#pragma unroll
    EPI_ROWS { const int row = u.pm * 256 + ai * 128 + m * 16 + rl0;
        const float* rs = (EKIND == EK_RES_X) ? (row < TP ? E.xp + (size_t)row * DM : E.xs + (size_t)(row - TP) * DM) : E.out + (size_t)row * DM;
        float ss = 0.f;
#pragma unroll
        for (int bj = 0; bj < 2; ++bj) { const int c = u.pn * 256 + bj * 128 + cl0;
            const f32x4 y0 = *(const f32x4*)(rs + c) + acc[ai][bj][m][0], y1 = *(const f32x4*)(rs + c + 4) + acc[ai][bj][m][1];
            *(f32x4*)(E.out + (size_t)row * DM + c) = y0; *(f32x4*)(E.out + (size_t)row * DM + c + 4) = y1;
            if (EKIND != EK_RES_NOB) *(u32x4*)(O + (size_t)row * DM + c) = pack8(y0, y1);
            ss += sumsq8(y0, y1); }
        ss = fq_sum(ss);
        if (fq == 0) PS[(size_t)row * 16 + u.pn * 4 + wc] = ss;
        EPI_FENCE(); }
}
template <int OMIB> __device__ __forceinline__ void epi_rowscale(EPI_ARGS) {
    const int rl0 = wr * 64 + fr, cl0 = wc * 32 + 8 * fq;
    bf16_t* O = (bf16_t*)(E.ws + (size_t)OMIB * MiB); const float* PS = (const float*)(E.ws + WS_PS);
#pragma unroll
    EPI_ROWS { const int row = u.pm * 256 + ai * 128 + m * 16 + rl0; const float r = row_r16(PS, row, fq);
#pragma unroll
        for (int bj = 0; bj < 2; ++bj) *(u32x4*)(O + (size_t)row * 1024 + u.pn * 256 + bj * 128 + cl0) = pack8(acc[ai][bj][m][0] * r, acc[ai][bj][m][1] * r);
        EPI_FENCE(); }
}
template <int OMIB> __device__ __forceinline__ void epi_swiglu(EPI_ARGS) {
    const int rl0 = wr * 64 + fr, cl0 = wc * 32 + 8 * fq;
    bf16_t* O = (bf16_t*)(E.ws + (size_t)OMIB * MiB); const float* PS = (const float*)(E.ws + WS_PS);
#pragma unroll
    EPI_ROWS { const int row = u.pm * 256 + ai * 128 + m * 16 + rl0; const float r = row_r16(PS, row, fq);
        f32x4 h[2];
#pragma unroll
        for (int n = 0; n < 2; ++n)
#pragma unroll
            for (int e = 0; e < 4; ++e) { const float g = acc[ai][0][m][n][e] * r, up = acc[ai][1][m][n][e] * r;
                h[n][e] = g * __builtin_amdgcn_rcpf(1.0f + __builtin_amdgcn_exp2f(-g * LOG2E)) * up; }
        *(u32x4*)(O + (size_t)row * DFF + u.pn * 128 + cl0) = pack8(h[0], h[1]);
        EPI_FENCE(); }
}
template <int OMIB> __device__ __forceinline__ void epi_softmax(EPI_ARGS) {
    const int rl0 = wr * 64 + fr, cl0 = wc * 32 + 8 * fq;
    bf16_t* O = (bf16_t*)(E.ws + (size_t)OMIB * MiB);
    LAS f32x2* TB = (LAS f32x2*)(lds + LDS_SMX);
    float mloc[2][4];
#pragma unroll
    EPI_ROWS {
        float mx = -3.0e38f;
#pragma unroll
        for (int bj = 0; bj < 2; ++bj)
#pragma unroll
            for (int n = 0; n < 2; ++n)
#pragma unroll
                for (int e = 0; e < 4; ++e) mx = fmaxf(mx, acc[ai][bj][m][n][e]);
        mx = fq_max(mx); float s = 0.f;
#pragma unroll
        for (int bj = 0; bj < 2; ++bj)
#pragma unroll
            for (int n = 0; n < 2; ++n)
#pragma unroll
                for (int e = 0; e < 4; ++e) { const float p = __builtin_amdgcn_exp2f(acc[ai][bj][m][n][e] - mx); acc[ai][bj][m][n][e] = p; s += p; }
        s = fq_sum(s); mloc[ai][m] = mx;
        if (fq == 0) TB[(ai * 128 + m * 16 + rl0) * 4 + wc] = (f32x2){mx, s};
    }
    LDS_WAIT(); __builtin_amdgcn_s_barrier(); asm volatile("" ::: "memory");
#pragma unroll
    EPI_ROWS { const int rl = ai * 128 + m * 16 + rl0; const int row = u.pm * 256 + rl;
        const f32x2 t0 = TB[rl * 4 + 0], t1 = TB[rl * 4 + 1], t2 = TB[rl * 4 + 2], t3 = TB[rl * 4 + 3];
        const float M = fmaxf(fmaxf(t0.x, t1.x), fmaxf(t2.x, t3.x));
        const float L = t0.y * __builtin_amdgcn_exp2f(t0.x - M) + t1.y * __builtin_amdgcn_exp2f(t1.x - M) + t2.y * __builtin_amdgcn_exp2f(t2.x - M) + t3.y * __builtin_amdgcn_exp2f(t3.x - M);
        const float f = __builtin_amdgcn_exp2f(mloc[ai][m] - M) * __builtin_amdgcn_rcpf(L);
#pragma unroll
        for (int bj = 0; bj < 2; ++bj) *(u32x4*)(O + (size_t)row * 1024 + u.pn * 256 + bj * 128 + cl0) = pack8(acc[ai][bj][m][0] * f, acc[ai][bj][m][1] * f); }
    LDS_WAIT(); __builtin_amdgcn_s_barrier(); asm volatile("" ::: "memory");
}
template <int EKIND, int OMIB> __device__ __forceinline__ void epilogue(EPI_ARGS) {
    if constexpr (EKIND == EK_P1) epi_p1(E, acc, u, wr, wc, fr, fq, lds);
    else if constexpr (EKIND == EK_Q) epi_q(E, acc, u, wr, wc, fr, fq, lds);
    else if constexpr (EKIND == EK_KV) epi_kv(E, acc, u, wr, wc, fr, fq, lds);
    else if constexpr (EKIND == EK_DFT) epi_plain<OMIB>(E, acc, u, wr, wc, fr, fq, lds, u.ty * SEQ + u.pm * 256, 512 + u.pn * 256);
    else if constexpr (EKIND == EK_RES || EKIND == EK_RES_X || EKIND == EK_RES_NOB) epi_res<EKIND, OMIB>(E, acc, u, wr, wc, fr, fq, lds);
    else if constexpr (EKIND == EK_ROWSCALE) epi_rowscale<OMIB>(E, acc, u, wr, wc, fr, fq, lds);
    else if constexpr (EKIND == EK_PLAIN) epi_plain<OMIB>(E, acc, u, wr, wc, fr, fq, lds, u.pm * 256, u.pn * 256);
    else if constexpr (EKIND == EK_SWIGLU) epi_swiglu<OMIB>(E, acc, u, wr, wc, fr, fq, lds);
    else epi_softmax<OMIB>(E, acc, u, wr, wc, fr, fq, lds);
}

template <int SKIND, int NN, int LDA, int LDB, int K, int EKIND, int OMIB>
__device__ __forceinline__ void gemm_phase(LAS unsigned char* lds, const Sched<SKIND, NN, LDA, LDB>& S, const Epi& E) {
    constexpr int lda = LDA, ldb = LDB;
    using namespace pg8;
    const int tid = threadIdx.x, wid = __builtin_amdgcn_readfirstlane(tid >> 6), lane = tid & 63, wr = wid >> 2, wc = wid & 3, fr = lane & 15, fq = lane >> 4;
    const int nt = K / BK;
    unsigned voffA[2], voffB[2];
#pragma unroll
    for (int i = 0; i < 2; ++i) { int R, C; stage_rc(tid * 16 + i * 8192, R, C); const int Rb = (R & ~31) + perm32(R & 31);
        voffA[i] = (unsigned)(R * lda + C) * 2u; voffB[i] = (unsigned)(Rb * ldb + C) * 2u; }
    const size_t kstep = (size_t)(BK * 2);
    const size_t hstepA = (size_t)HALF * lda * 2, hstepB = (size_t)HALF * ldb * 2;
    const unsigned ldsw = (unsigned)wid * 1024u;
    const int aoff = lds_byte(wr * 64 + fr, fq * 8), boff = lds_byte(wc * 32 + fr, fq * 8);
#define PG8_SA(b, h) (((b) * 2 + (h)) * HTB)
#define PG8_SB(b, h) ((4 + (b) * 2 + (h)) * HTB)
#define PG8_STAGE(bufoff, gbase, voff) do { _Pragma("unroll") for (int _i = 0; _i < 2; ++_i) \
        __builtin_amdgcn_global_load_lds((const unsigned*)((const char*)(gbase) + (voff)[_i]), (LAS unsigned*)(lds + (bufoff) + ldsw + _i * 8192), 16, 0, 0); } while (0)
#define PG8_LDA(dst, b, h) do { _Pragma("unroll") for (int m = 0; m < 4; ++m) _Pragma("unroll") for (int k = 0; k < 2; ++k) dst[m][k] = *(const LAS bf16x8*)(lds + PG8_SA(b, h) + aoff + m * 2048 + k * 1024); } while (0)
#define PG8_LDB(dst, b, h) do { _Pragma("unroll") for (int n = 0; n < 2; ++n) _Pragma("unroll") for (int k = 0; k < 2; ++k) dst[n][k] = *(const LAS bf16x8*)(lds + PG8_SB(b, h) + boff + n * 2048 + k * 1024); } while (0)
#define PG8_MMA(ai, bj, At, Bt) do { __builtin_amdgcn_s_setprio(1); _Pragma("unroll") for (int m = 0; m < 4; ++m) _Pragma("unroll") for (int n = 0; n < 2; ++n) _Pragma("unroll") for (int k = 0; k < 2; ++k) \
        acc[ai][bj][m][n] = __builtin_amdgcn_mfma_f32_16x16x32_bf16(Bt[n][k], At[m][k], acc[ai][bj][m][n], 0, 0, 0); __builtin_amdgcn_s_setprio(0); } while (0)
#define PG8_WAIT_V(n) asm volatile("s_waitcnt vmcnt(" #n ")" ::: "memory")
#define PG8_WAIT_L(n) asm volatile("s_waitcnt lgkmcnt(" #n ")" ::: "memory")
#define PG8_BAR __builtin_amdgcn_s_barrier()
#define PG8_SCHED __builtin_amdgcn_sched_barrier(0)
    Unit cur, nxt; int ui = 0;
    if (!S.next(0, cur)) return;
    f32x4 acc[2][2][4][2];
#pragma unroll
    for (int a = 0; a < 2; ++a)
#pragma unroll
        for (int b = 0; b < 2; ++b)
#pragma unroll
            for (int m = 0; m < 4; ++m)
#pragma unroll
                for (int n = 0; n < 2; ++n) acc[a][b][m][n] = (f32x4){0.f, 0.f, 0.f, 0.f};
    bf16x8 At[4][2], B0[2][2], B1[2][2];
    const char* cA = cur.a; const char* cB = cur.b;
    PG8_STAGE(PG8_SB(0, 0), cB, voffB); PG8_STAGE(PG8_SB(0, 1), cB + hstepB, voffB); PG8_STAGE(PG8_SA(0, 0), cA, voffA); PG8_STAGE(PG8_SA(0, 1), cA + hstepA, voffA);
    if (wr == 1) PG8_BAR;
    PG8_WAIT_V(2); PG8_BAR;
    PG8_STAGE(PG8_SB(1, 0), cB + kstep, voffB); PG8_STAGE(PG8_SA(1, 0), cA + kstep, voffA); PG8_STAGE(PG8_SB(1, 1), cB + hstepB + kstep, voffB);
    PG8_WAIT_V(6); PG8_BAR;
    for (;;) {
        const bool has_next = S.next(ui + 1, nxt);
        const char* nA = has_next ? nxt.a : cA; const char* nB = has_next ? nxt.b : cB;
#pragma unroll 1
        for (int t = 0; t < nt; t += 2) {
            const bool last = (t == nt - 2);
            const char* a1 = cA + (size_t)(t + 1) * kstep;
            const char* a2 = last ? nA : cA + (size_t)(t + 2) * kstep; const char* b2 = last ? nB : cB + (size_t)(t + 2) * kstep;
            const char* a3 = a2 + kstep; const char* b3 = b2 + kstep;
            PG8_LDB(B0, 0, 0); PG8_LDB(B1, 0, 1); PG8_SCHED; PG8_LDA(At, 0, 0); PG8_STAGE(PG8_SA(1, 1), a1 + hstepA, voffA);
            PG8_WAIT_V(8); PG8_WAIT_L(0); PG8_BAR; PG8_MMA(0, 0, At, B0); PG8_MMA(0, 1, At, B1); PG8_BAR; PG8_SCHED;
            PG8_LDA(At, 0, 1); PG8_STAGE(PG8_SB(0, 0), b2, voffB); PG8_STAGE(PG8_SB(0, 1), b2 + hstepB, voffB); PG8_STAGE(PG8_SA(0, 0), a2, voffA);
            PG8_WAIT_V(8); PG8_WAIT_L(0); PG8_BAR; PG8_MMA(1, 0, At, B0); PG8_MMA(1, 1, At, B1); PG8_BAR; PG8_SCHED;
            PG8_LDB(B0, 1, 0); PG8_LDB(B1, 1, 1); PG8_SCHED; PG8_LDA(At, 1, 0); PG8_STAGE(PG8_SA(0, 1), a2 + hstepA, voffA);
            PG8_WAIT_V(8); PG8_WAIT_L(0); PG8_BAR; PG8_MMA(0, 0, At, B0); PG8_MMA(0, 1, At, B1); PG8_BAR; PG8_SCHED;
            PG8_LDA(At, 1, 1); PG8_STAGE(PG8_SB(1, 0), b3, voffB); PG8_STAGE(PG8_SB(1, 1), b3 + hstepB, voffB); PG8_STAGE(PG8_SA(1, 0), a3, voffA);
            PG8_WAIT_V(8); PG8_WAIT_L(0); PG8_BAR; PG8_MMA(1, 0, At, B0); PG8_MMA(1, 1, At, B1); PG8_BAR; PG8_SCHED;
        }
        if (wr == 0) PG8_BAR;
        epilogue<EKIND, OMIB>(E, acc, cur, wr, wc, fr, fq, lds);
        if (!has_next) break;
#pragma unroll
        for (int a = 0; a < 2; ++a)
#pragma unroll
            for (int b = 0; b < 2; ++b)
#pragma unroll
                for (int m = 0; m < 4; ++m)
#pragma unroll
                    for (int n = 0; n < 2; ++n) acc[a][b][m][n] = (f32x4){0.f, 0.f, 0.f, 0.f};
        cur = nxt; cA = nA; cB = nB; ++ui;
        if (wr == 1) PG8_BAR;
    }
    PG8_WAIT_V(0);
    PG8_BAR;
#undef PG8_SA
#undef PG8_SB
#undef PG8_STAGE
#undef PG8_LDA
#undef PG8_LDB
#undef PG8_MMA
#undef PG8_WAIT_V
#undef PG8_WAIT_L
#undef PG8_BAR
#undef PG8_SCHED
}

namespace mla {
constexpr int NW = 8, QBLK = 32, KVBLK = 64;
constexpr int SHM_V = KVBLK * DVH * 2, SHM_K = KVBLK * 256;
constexpr int OFF_V = 0, OFF_K = 2 * SHM_V, OFF_WS = OFF_K + 2 * SHM_K, OFF_OST = OFF_WS + NW * 64 * 4, BYTES = OFF_OST + NW * 4096;
constexpr float THR = 11.5f;
#define KSWZ(row, colB) ((row) * 256 + ((colB) ^ (((row) & 7) << 4)))
#define SBAR() __builtin_amdgcn_sched_barrier(0)
__device__ __forceinline__ int crow(int r, int hi) { return (r & 3) + 8 * (r >> 2) + 4 * hi; }
__device__ __forceinline__ void partialSM(f32x16& p0, f32x16& p1, float& m_reg, float& mn, float& alpha) {
    float pmax = p0[0];
#pragma unroll
    for (int r = 1; r < 16; ++r) pmax = fmaxf(pmax, p0[r]);
#pragma unroll
    for (int r = 0; r < 16; ++r) pmax = fmaxf(pmax, p1[r]);
    { auto rr = __builtin_amdgcn_permlane32_swap(__float_as_uint(pmax), __float_as_uint(pmax), false, false); pmax = fmaxf(__uint_as_float(rr[0]), __uint_as_float(rr[1])); }
    if (__builtin_expect(__all(pmax - m_reg <= THR), 1)) { mn = m_reg; alpha = 1.f; }
    else { mn = fmaxf(m_reg, pmax); alpha = __builtin_amdgcn_exp2f(m_reg - mn); m_reg = mn; }
#pragma unroll
    for (int r = 0; r < 16; ++r) p0[r] = p0[r] - mn;
#pragma unroll
    for (int r = 0; r < 16; ++r) p1[r] = p1[r] - mn;
#pragma unroll
    for (int r = 0; r < 16; ++r) p0[r] = __builtin_amdgcn_exp2f(p0[r]);
}
__device__ __forceinline__ void finishSM(f32x16& p0, f32x16& p1, float alpha, float& l_reg, bf16x8& pa0, bf16x8& pa1, bf16x8& pa2, bf16x8& pa3) {
#pragma unroll
    for (int r = 0; r < 16; ++r) p1[r] = __builtin_amdgcn_exp2f(p1[r]);
    float ps = 0;
#pragma unroll
    for (int r = 0; r < 16; ++r) ps += p0[r];
#pragma unroll
    for (int r = 0; r < 16; ++r) ps += p1[r];
    { auto rr = __builtin_amdgcn_permlane32_swap(__float_as_uint(ps), __float_as_uint(ps), false, false); ps = __uint_as_float(rr[0]) + __uint_as_float(rr[1]); }
    l_reg = l_reg * alpha + ps;
#define PK4(P, BASE, OUT) do { unsigned a0 = cvt_pk_bf16(P[BASE + 0], P[BASE + 1]), a1 = cvt_pk_bf16(P[BASE + 2], P[BASE + 3]);   \
    unsigned b0 = cvt_pk_bf16(P[BASE + 4], P[BASE + 5]), b1 = cvt_pk_bf16(P[BASE + 6], P[BASE + 7]);                              \
    auto r0 = __builtin_amdgcn_permlane32_swap(a0, b0, false, false); auto r1 = __builtin_amdgcn_permlane32_swap(a1, b1, false, false); \
    u32x4 w = {r0[0], r1[0], r0[1], r1[1]}; OUT = *reinterpret_cast<bf16x8*>(&w); } while (0)
    PK4(p0, 0, pa0); PK4(p0, 8, pa1); PK4(p1, 0, pa2); PK4(p1, 8, pa3);
#undef PK4
}
__device__ __forceinline__ void qkt(f32x16& p0, f32x16& p1, const char* Ks, const bf16x8* qr, int r32, int hi) {
    p0 = f32x16{}; p1 = f32x16{};
#pragma unroll
    for (int d0 = 0; d0 < DQK / 16; ++d0) { const int cb = (d0 * 16 + hi * 8) * 2;
        const bf16x8 b0 = *reinterpret_cast<const bf16x8*>(Ks + KSWZ(r32, cb));
        const bf16x8 b1 = *reinterpret_cast<const bf16x8*>(Ks + KSWZ(32 + r32, cb));
        p0 = __builtin_amdgcn_mfma_f32_32x32x16_bf16(b0, qr[d0], p0, 0, 0, 0);
        p1 = __builtin_amdgcn_mfma_f32_32x32x16_bf16(b1, qr[d0], p1, 0, 0, 0); }
}
__device__ __forceinline__ int v_st(int k, int c) { const int kk = (k & ~0xC) | ((k & 4) << 1) | ((k & 8) >> 1); return ((kk >> 3) * 2 + (c >> 5)) * 512 + ((kk & 7) * 32 + (c & 31)) * 2; }
__device__ __forceinline__ int v_rd_base(int lane) { return ((lane & 3) << 3) | (((lane >> 2) & 3) << 6) | (((lane >> 4) & 1) << 5) | (((lane >> 5) & 1) << 8); }
constexpr int v_rd_off(int d0, int ks, int half) { return d0 * 512 + ks * 2048 + half * 1024; }
template <int OFF> __device__ __forceinline__ s16x4 tr_read(int vb) { s16x4 r; asm volatile("ds_read_b64_tr_b16 %0, %1 offset:%2" : "=&v"(r) : "v"(vb), "i"(OFF) : "memory"); return r; }
template <int D0> __device__ __forceinline__ void pv_one(f32x16& od, int vb, bf16x8 pa0, bf16x8 pa1, bf16x8 pa2, bf16x8 pa3) {
    const s16x4 l0 = tr_read<v_rd_off(D0, 0, 0)>(vb), h0 = tr_read<v_rd_off(D0, 0, 1)>(vb), l1 = tr_read<v_rd_off(D0, 1, 0)>(vb), h1 = tr_read<v_rd_off(D0, 1, 1)>(vb);
    const s16x4 l2 = tr_read<v_rd_off(D0, 2, 0)>(vb), h2 = tr_read<v_rd_off(D0, 2, 1)>(vb), l3 = tr_read<v_rd_off(D0, 3, 0)>(vb), h3 = tr_read<v_rd_off(D0, 3, 1)>(vb);
    asm volatile("s_waitcnt lgkmcnt(0)" ::: "memory"); SBAR();
#define PK(L, H) (bf16x8){L[0], L[1], L[2], L[3], H[0], H[1], H[2], H[3]}
    od = __builtin_amdgcn_mfma_f32_32x32x16_bf16(pa0, PK(l0, h0), od, 0, 0, 0);
    od = __builtin_amdgcn_mfma_f32_32x32x16_bf16(pa1, PK(l1, h1), od, 0, 0, 0);
    od = __builtin_amdgcn_mfma_f32_32x32x16_bf16(pa2, PK(l2, h2), od, 0, 0, 0);
    od = __builtin_amdgcn_mfma_f32_32x32x16_bf16(pa3, PK(l3, h3), od, 0, 0, 0);
#undef PK
}
__device__ __forceinline__ void pv_d0(f32x16* o, int vb, bf16x8 pa0, bf16x8 pa1, bf16x8 pa2, bf16x8 pa3) {
    pv_one<0>(o[0], vb, pa0, pa1, pa2, pa3); pv_one<1>(o[1], vb, pa0, pa1, pa2, pa3);
}
__device__ __forceinline__ void attn_unit(const bf16_t* __restrict__ Qb, const bf16_t* __restrict__ Kh, const bf16_t* __restrict__ Vh, bf16_t* __restrict__ Ob, char* lds) {
    constexpr int LDQ = 768, LDK = 768, LDV = 512, LDO = 1024;
    const int tid = threadIdx.x, wid = tid >> 6, lane = tid & 63, r32 = lane & 31, hi = lane >> 5;
    char* V_lds = lds + OFF_V; char* K_lds = lds + OFF_K;
    float* ws = (float*)(lds + OFF_WS) + wid * 64; float* li_l = ws; float* al_l = ws + 32;
    float m_reg = -1e30f, l_reg = 0; f32x16 o[2] = {}; bf16x8 qr[DQK / 16];
    const bf16_t* Qw = Qb + (size_t)(wid * QBLK + r32) * LDQ + hi * 8;
#pragma unroll
    for (int d0 = 0; d0 < DQK / 16; ++d0) qr[d0] = *reinterpret_cast<const bf16x8*>(Qw + d0 * 16);
    const int vr = tid >> 3, vc = (tid & 7) * 8, vst = v_st(vr, vc);
    const int kr0 = tid >> 3, kc0 = (tid & 7) * 8, kst0 = KSWZ(kr0, kc0 * 2);
    const bool k1 = tid < 256; const int kr1 = (tid >> 2) & 63, kc1 = 64 + (tid & 3) * 8, kst1 = KSWZ(kr1, kc1 * 2);
    const int vb0 = (int)(uintptr_t)V_lds + v_rd_base(lane);
    struct { bf16x8 vs, ks0, ks1; } sr_[2];
#define SLOAD(i, k0) do { sr_[i].vs = *reinterpret_cast<const bf16x8*>(&Vh[(size_t)((k0) + vr) * LDV + vc]); \
    sr_[i].ks0 = *reinterpret_cast<const bf16x8*>(&Kh[(size_t)((k0) + kr0) * LDK + kc0]); \
    if (k1) sr_[i].ks1 = *reinterpret_cast<const bf16x8*>(&Kh[(size_t)((k0) + kr1) * LDK + kc1]); } while (0)
#define SWRITE(b, i) do { *(bf16x8*)(V_lds + (b) * SHM_V + vst) = sr_[i].vs; *(bf16x8*)(K_lds + (b) * SHM_K + kst0) = sr_[i].ks0; \
    if (k1) *(bf16x8*)(K_lds + (b) * SHM_K + kst1) = sr_[i].ks1; } while (0)
#define RESC(a) do { if (__any((a) < 1.f)) { if (hi == 0) al_l[r32] = (a); asm volatile("s_waitcnt lgkmcnt(0)" ::: "memory"); \
    _Pragma("unroll") for (int d = 0; d < 2; ++d) _Pragma("unroll") for (int r = 0; r < 16; ++r) o[d][r] *= al_l[crow(r, hi)]; } } while (0)
    f32x16 pA0, pA1, pB0, pB1; float mnA, mnB, alA, alB; bf16x8 pa0, pa1, pa2, pa3; constexpr int NT = SEQ / KVBLK;
    constexpr int SE = 0, SO = 1;
    SLOAD(SE, 0); asm volatile("s_waitcnt vmcnt(0)" ::: "memory"); SWRITE(0, SE); __syncthreads();
    qkt(pA0, pA1, K_lds, qr, r32, hi); partialSM(pA0, pA1, m_reg, mnA, alA);
    SLOAD(SO, KVBLK); SLOAD(SE, 2 * KVBLK);
    SWRITE(1, SO); __syncthreads();
    for (int j = 1; j + 1 < NT; j += 2) {
        SBAR(); qkt(pB0, pB1, K_lds + SHM_K, qr, r32, hi);
        finishSM(pA0, pA1, alA, l_reg, pa0, pa1, pa2, pa3); SBAR();
        SLOAD(SO, (j + 2) * KVBLK); SBAR();
        pv_d0(o, vb0, pa0, pa1, pa2, pa3); partialSM(pB0, pB1, m_reg, mnB, alB);
        __syncthreads(); SWRITE(0, SE);
        RESC(alB); __syncthreads();
        SBAR(); qkt(pA0, pA1, K_lds, qr, r32, hi);
        finishSM(pB0, pB1, alB, l_reg, pa0, pa1, pa2, pa3); SBAR();
        if (j + 3 < NT) SLOAD(SE, (j + 3) * KVBLK); SBAR();
        pv_d0(o, vb0 + SHM_V, pa0, pa1, pa2, pa3); partialSM(pA0, pA1, m_reg, mnA, alA);
        __syncthreads(); SWRITE(1, SO);
        RESC(alA); __syncthreads();
    }
    SBAR(); qkt(pB0, pB1, K_lds + SHM_K, qr, r32, hi);
    finishSM(pA0, pA1, alA, l_reg, pa0, pa1, pa2, pa3); SBAR();
    pv_d0(o, vb0, pa0, pa1, pa2, pa3); partialSM(pB0, pB1, m_reg, mnB, alB);
    __syncthreads(); RESC(alB);
    finishSM(pB0, pB1, alB, l_reg, pa0, pa1, pa2, pa3); SBAR();
    pv_d0(o, vb0 + SHM_V, pa0, pa1, pa2, pa3);
    if (hi == 0) li_l[r32] = l_reg; asm volatile("s_waitcnt lgkmcnt(0)" ::: "memory");
    float rli[16];
#pragma unroll
    for (int r = 0; r < 16; ++r) rli[r] = __builtin_amdgcn_rcpf(li_l[crow(r, hi)]);
    {
        bf16_t* stg = (bf16_t*)(lds + OFF_OST) + wid * 2048;
#pragma unroll
        for (int r = 0; r < 16; ++r) { const int orow = crow(r, hi);
#pragma unroll
            for (int d0 = 0; d0 < 2; ++d0) stg[orow * 64 + d0 * 32 + r32] = (bf16_t)(cvt_pk_bf16(o[d0][r] * rli[r], 0.f) & 0xffffu); }
        asm volatile("s_waitcnt lgkmcnt(0)" ::: "memory");
        bf16_t* Ow = Ob + (size_t)(wid * QBLK) * LDO;
#pragma unroll
        for (int i = 0; i < 4; ++i) { const int row = i * 8 + (lane >> 3), ch = lane & 7; const u32x4 v = *(const u32x4*)(stg + row * 64 + ch * 8); *(u32x4*)(Ow + (size_t)row * LDO + ch * 8) = v; }
    }
    __syncthreads();
#undef SLOAD
#undef SWRITE
#undef RESC
}
#undef KSWZ
#undef SBAR
}

#define XB_TMO      128
#define XB_XCNT(j)  (256  + 64 * (j))
#define XB_XSUB(j)  (1280 + 64 * (j))
#define XB_XGEN(j)  (2304 + 64 * (j))
#define XB_TOP      3328
#define XB_TOPGEN   3392
#define XCD_BAR_WORDS 3456
#define XB_SPIN_CAP (1u << 18)
__device__ __forceinline__ unsigned xb_ld(unsigned* p)              { return __hip_atomic_load(p, __ATOMIC_RELAXED, __HIP_MEMORY_SCOPE_AGENT); }
__device__ __forceinline__ unsigned xb_add(unsigned* p, unsigned v) { return __hip_atomic_fetch_add(p, v, __ATOMIC_RELAXED, __HIP_MEMORY_SCOPE_AGENT); }
__device__ __forceinline__ unsigned xb_xcc_id() { return (unsigned)__builtin_amdgcn_s_getreg((3 << 11) | 20) & 0xFu; }
#define XB_SPIN(cond, bar) do { unsigned _sp = 0; while (cond) { __builtin_amdgcn_s_sleep(1); \
    if ((++_sp & 255u) == 0u) { if (xb_ld(&(bar)[XB_TMO])) break; if (_sp > XB_SPIN_CAP) { atomicAdd(&(bar)[XB_TMO], 1u); break; } } } } while (0)
struct XcdBarrier { unsigned* bar; unsigned x; volatile LAS unsigned* st; };
__device__ __forceinline__ XcdBarrier xcd_barrier_post(unsigned* bar, volatile LAS unsigned* st) {
    XcdBarrier b; b.bar = bar; b.x = xb_xcc_id(); b.st = st;
    if (threadIdx.x == 0) (void)xb_add(&bar[XB_XCNT(b.x)], 1u);
    return b;
}
__device__ __forceinline__ void xcd_barrier_complete(unsigned* bar, unsigned x, unsigned& nloc, unsigned& nx) {
    const unsigned G = gridDim.x * gridDim.y * gridDim.z;
    unsigned sum, cnt, mine, sp = 0u;
    for (;;) {
        sum = 0u; cnt = 0u; mine = 0u;
#pragma unroll
        for (unsigned j = 0; j < 16; ++j) { const unsigned c = xb_ld(&bar[XB_XCNT(j)]); sum += c; cnt += (c > 0u) ? 1u : 0u; mine = (j == x) ? c : mine; }
        if (sum == G) break;
        __builtin_amdgcn_s_sleep(1);
        if ((++sp & 255u) == 0u) { if (xb_ld(&bar[XB_TMO])) break; if (sp > XB_SPIN_CAP) { atomicAdd(&bar[XB_TMO], 1u); break; } }
    }
    nloc = mine > 0u ? mine : 1u; nx = cnt > 0u ? cnt : 1u;
}
__device__ __forceinline__ void xcd_barrier(const XcdBarrier& b) {
    asm volatile("s_waitcnt vmcnt(0)" ::: "memory");
    __syncthreads();
    if (threadIdx.x == 0) {
        unsigned* bar = b.bar;
        __builtin_amdgcn_s_waitcnt(0);
        unsigned nloc = b.st[0], nx = b.st[1];
        if (nloc == 0u) { xcd_barrier_complete(bar, b.x, nloc, nx); b.st[0] = nloc; b.st[1] = nx; }
        const unsigned old = xb_add(&bar[XB_XSUB(b.x)], 1u);
        const unsigned gen = old / nloc;
        if (old + 1u == (gen + 1u) * nloc) {
            __builtin_amdgcn_fence(__ATOMIC_RELEASE, "agent");
            asm volatile("s_waitcnt vmcnt(0)" ::: "memory");
            const unsigned og = xb_add(&bar[XB_TOP], 1u);
            const unsigned tg = og / nx;
            if (og + 1u == (tg + 1u) * nx) xb_add(&bar[XB_TOPGEN], 1u);
            else XB_SPIN(xb_ld(&bar[XB_TOPGEN]) == tg, bar);
            __builtin_amdgcn_fence(__ATOMIC_ACQUIRE, "agent");
            xb_add(&bar[XB_XGEN(b.x)], 1u);
            asm volatile("s_waitcnt vmcnt(0)" ::: "memory");
        } else {
            XB_SPIN(xb_ld(&bar[XB_XGEN(b.x)]) == gen, bar);
            __builtin_amdgcn_fence(__ATOMIC_ACQUIRE, "agent");
            asm volatile("s_waitcnt vmcnt(0)" ::: "memory");
        }
    }
    __syncthreads();
}

constexpr int NWAVES = 8;
constexpr int MISC_OFF = 139264 + 64;
constexpr int LDS_BYTES = 147456;
struct Frame { LAS unsigned char* lds; int tid, lane, wave, vcu, G; float* out; unsigned char* ws; };
struct Args { const float* in[21]; float* out; unsigned char* ws; int st_lo, st_hi; };

template <class F> __device__ __forceinline__ void transpose_item(const F& f, int item, int nblk, bf16_t* dst, int ldd, LAS float* scr, int lane) {
    const int kb = item / nblk, nb = item % nblk, k0 = 64 * kb, n0 = 32 * nb;
#pragma unroll 8
    for (int i = 0; i < 32; ++i) { const int kk = 2 * i + (lane >> 5); scr[kk * 33 + (lane & 31)] = f(k0 + kk, n0 + (lane & 31)); }
    LDS_WAIT(); asm volatile("" ::: "memory");
    const int c = lane & 7;
#pragma unroll
    for (int j = 0; j < 4; ++j) { const int n = (lane >> 3) + 8 * j; const LAS float* s = scr + (8 * c) * 33 + n;
        u32x4 o; o.x = cvt_pk_bf16(s[0 * 33], s[1 * 33]); o.y = cvt_pk_bf16(s[2 * 33], s[3 * 33]); o.z = cvt_pk_bf16(s[4 * 33], s[5 * 33]); o.w = cvt_pk_bf16(s[6 * 33], s[7 * 33]);
        *(u32x4*)(dst + (size_t)(n0 + n) * ldd + k0 + 8 * c) = o; }
    LDS_WAIT(); asm volatile("" ::: "memory");
}
__device__ __forceinline__ int rope_perm(int p) { return (p >> 1) + 16 * (p & 1); }
struct SrcWz { const float* w; __device__ __forceinline__ float operator()(int k, int n) const {
    if (n < 640) return w[(size_t)k * INW + n]; if (n < 672) return w[(size_t)k * INW + 640 + rope_perm(n - 640)]; return 0.f; } };
struct SrcPlain { const float* w; int ld, coff; __device__ __forceinline__ float operator()(int k, int n) const { return w[(size_t)k * ld + coff + n]; } };
struct SrcGain { const float* w; const float* g; int ld; float sc; __device__ __forceinline__ float operator()(int k, int n) const { return w[(size_t)k * ld + n] * g[k] * sc; } };
struct SrcUq { const float* w; const float* g; __device__ __forceinline__ float operator()(int k, int n) const {
    const int h = n / DQK, e = n % DQK; const int src = h * DQK + (e < DN ? e : DN + rope_perm(e - DN)); return w[(size_t)k * 768 + src] * g[k] * QSCALE; } };
struct SrcGu { const float* w; const float* g; __device__ __forceinline__ float operator()(int k, int n) const {
    const int t = n >> 8, j = n & 255; const int src = (j < 128) ? (128 * t + j) : (DFF + 128 * t + (j - 128)); return w[(size_t)k * (2 * DFF) + src] * g[k]; } };

__constant__ double ROPE_INV[16] = {1.0, 0.5623413251903491, 0.31622776601683794, 0.1778279410038923, 0.1, 0.05623413251903491, 0.03162277660168379, 0.01778279410038923,
                                    0.01, 0.005623413251903491, 0.0031622776601683794, 0.0017782794100389228, 0.001, 0.0005623413251903491, 0.00031622776601683794, 0.00017782794100389227};

__device__ __forceinline__ void rms_row_to_bf16(const float* xrow, const f32x4 (&g)[4], bf16_t* orow, int lane) {
    const f32x4* xr = (const f32x4*)xrow + lane;
    f32x4 v[4]; float s = 0.f;
#pragma unroll
    for (int j = 0; j < 4; ++j) { v[j] = xr[64 * j]; s += (v[j][0] * v[j][0] + v[j][1] * v[j][1]) + (v[j][2] * v[j][2] + v[j][3] * v[j][3]); }
    const float r = __builtin_amdgcn_rsqf(wave_sum(s) * (1.f / DM) + EPS);
    u32x2* o8 = (u32x2*)orow + lane;
#pragma unroll
    for (int j = 0; j < 4; ++j) { const f32x4 y = v[j] * g[j] * r; u32x2 w; w.x = cvt_pk_bf16(y[0], y[1]); w.y = cvt_pk_bf16(y[2], y[3]); o8[64 * j] = w; }
}

__device__ __forceinline__ void p0_prologue(Frame& F, const Args& AR) {
    unsigned char* ws = F.ws; unsigned char* dob = (unsigned char*)F.out;
    bf16_t* WzT = (bf16_t*)(ws + WS_WZT); bf16_t* WfT = (bf16_t*)(ws + WS_WFT); bf16_t* WxkT = (bf16_t*)(ws + WS_WXKT); bf16_t* WxvT = (bf16_t*)(ws + WS_WXVT);
    bf16_t* WuqT = (bf16_t*)(ws + WS_WUQT); bf16_t* WukvT = (bf16_t*)(ws + WS_WUKVT); bf16_t* DFTM = (bf16_t*)(ws + WS_DFTM); bf16_t* WoutT = (bf16_t*)(ws + WS_WOUTT);
    bf16_t* WxqT = (bf16_t*)(ws + WS_WXQT); bf16_t* WxoT = (bf16_t*)(ws + WS_WXOT); bf16_t* WguT = (bf16_t*)(ws + WS_WGUT); bf16_t* WdT = (bf16_t*)(ws + WS_WDT);
    float* ropeC = (float*)(ws + WS_ROPEC); float* ropeS = (float*)(ws + WS_ROPES);
    bf16_t* XN = (bf16_t*)(ws + WS_R0); bf16_t* MN = (bf16_t*)(dob + DO_MN);
    const int gw = F.vcu * NWAVES + F.wave, NGW = F.G * NWAVES, gt = F.vcu * 512 + F.tid, NGT = F.G * 512;
    for (int it = F.vcu; it < 256; it += F.G) {
        const int g = it >> 6, k0 = (it & 63) * 16; LAS float* Wl = (LAS float*)F.lds;
#pragma unroll
        for (int e = 0; e < 4; ++e) { const int idx = F.tid + 512 * e; Wl[idx] = AR.in[5][(size_t)(k0 + (idx >> 7)) * INW + 672 + g * 128 + (idx & 127)]; }
        LDS_WAIT(); __syncthreads();
        const int nl = F.tid & 255, cs = nl >> 7, j = nl & 127, kh = F.tid >> 8; float a[8];
#pragma unroll
        for (int e = 0; e < 8; ++e) a[e] = 0.f;
        for (int c = 0; c < 128; ++c) { const float ph = (float)((j * c) & 127) * (1.0f / 128.0f); const float tv = cs ? __builtin_amdgcn_sinf(ph) : __builtin_amdgcn_cosf(ph);
#pragma unroll
            for (int e = 0; e < 8; ++e) a[e] += Wl[(kh * 8 + e) * 128 + c] * tv; }
        u32x4 o; o.x = cvt_pk_bf16(a[0], a[1]); o.y = cvt_pk_bf16(a[2], a[3]); o.z = cvt_pk_bf16(a[4], a[5]); o.w = cvt_pk_bf16(a[6], a[7]);
        *(u32x4*)(WfT + (size_t)(g * 256 + cs * 128 + j) * 1024 + k0 + kh * 8) = o;
        __syncthreads();
    }
    for (int it = F.vcu; it < 128; it += F.G) {
        const int g = it >> 5, n0 = (it & 31) * 32; LAS float* Wf = (LAS float*)F.lds; LAS float* Wo = (LAS float*)(F.lds + 65536);
#pragma unroll 8
        for (int e = 0; e < 32; ++e) { const int idx = F.tid + 512 * e; Wf[idx] = AR.in[10][(size_t)g * 16384 + idx]; }
#pragma unroll
        for (int e = 0; e < 8; ++e) { const int idx = F.tid + 512 * e; Wo[idx] = AR.in[11][(size_t)(512 + g * 128 + (idx >> 5)) * DM + n0 + (idx & 31)]; }
        LDS_WAIT(); __syncthreads();
        const int n = F.tid & 31, grp = F.tid >> 5; float a[8];
#pragma unroll
        for (int e = 0; e < 8; ++e) a[e] = 0.f;
        for (int c = 0; c < 128; ++c) { const float wv = Wo[c * 32 + n];
#pragma unroll
            for (int e = 0; e < 8; ++e) a[e] += Wf[(grp * 8 + e) * 128 + c] * wv; }
        u32x4 o; o.x = cvt_pk_bf16(a[0], a[1]); o.y = cvt_pk_bf16(a[2], a[3]); o.z = cvt_pk_bf16(a[4], a[5]); o.w = cvt_pk_bf16(a[6], a[7]);
        *(u32x4*)(WoutT + (size_t)(n0 + n) * 1024 + 512 + g * 128 + grp * 8) = o;
        __syncthreads();
    }
    {
        LAS float* scr = (LAS float*)(F.lds + F.wave * 16384);
        constexpr int I_WZ = 16 * 24, I_XK = 16 * 32, I_XV = 16 * 32, I_UQ = 6 * 24, I_UKV = 4 * 32, I_OUT = 8 * 32, I_XQ = 16 * 32, I_XO = 16 * 32, I_GU = 16 * 176, I_D = 44 * 32;
        constexpr int NITEMS = I_WZ + I_XK + I_XV + I_UQ + I_UKV + I_OUT + I_XQ + I_XO + I_GU + I_D;
        for (int it = gw; it < NITEMS; it += NGW) {
            int r = it;
            if (r < I_WZ) { transpose_item(SrcWz{AR.in[5]}, r, 24, WzT, 1024, scr, F.lane); continue; } r -= I_WZ;
            if (r < I_XK) { transpose_item(SrcPlain{AR.in[15], 2048, 0}, r, 32, WxkT, 1024, scr, F.lane); continue; } r -= I_XK;
            if (r < I_XV) { transpose_item(SrcPlain{AR.in[15], 2048, 1024}, r, 32, WxvT, 1024, scr, F.lane); continue; } r -= I_XV;
            if (r < I_UQ) { transpose_item(SrcUq{AR.in[7], AR.in[6]}, r, 24, WuqT, QL, scr, F.lane); continue; } r -= I_UQ;
            if (r < I_UKV) { transpose_item(SrcGain{AR.in[9], AR.in[8], 1024, 1.f}, r, 32, WukvT, KVL, scr, F.lane); continue; } r -= I_UKV;
            if (r < I_OUT) { transpose_item(SrcPlain{AR.in[11], 1024, 0}, r, 32, WoutT, 1024, scr, F.lane); continue; } r -= I_OUT;
            if (r < I_XQ) { transpose_item(SrcGain{AR.in[14], AR.in[12], 1024, XSCALE}, r, 32, WxqT, 1024, scr, F.lane); continue; } r -= I_XQ;
            if (r < I_XO) { transpose_item(SrcPlain{AR.in[16], 1024, 0}, r, 32, WxoT, 1024, scr, F.lane); continue; } r -= I_XO;
            if (r < I_GU) { transpose_item(SrcGu{AR.in[18], AR.in[17]}, r, 176, WguT, 1024, scr, F.lane); continue; } r -= I_GU;
            transpose_item(SrcPlain{AR.in[19], 1024, 0}, r, 32, WdT, DFF, scr, F.lane);
        }
    }
    for (int ch = gt; ch < 2048 * 512; ch += NGT) { const int k = ch >> 9, c0 = (ch & 511) * 8; float v[8];
#pragma unroll
        for (int e = 0; e < 8; ++e) { const int cc = c0 + e, s = cc & 2047; const float ph = (float)((k * s) & 2047) * (1.0f / 2048.0f);
            v[e] = (cc < 2048 ? __builtin_amdgcn_cosf(ph) : -__builtin_amdgcn_sinf(ph)) * (1.0f / 512.0f); }
        u32x4 o; o.x = cvt_pk_bf16(v[0], v[1]); o.y = cvt_pk_bf16(v[2], v[3]); o.z = cvt_pk_bf16(v[4], v[5]); o.w = cvt_pk_bf16(v[6], v[7]);
        *(u32x4*)(DFTM + (size_t)k * 4096 + c0) = o; }
    for (int idx = gt; idx < SEQ * 16; idx += NGT) { const int s = idx >> 4, i = idx & 15; const double rev = (double)s * ROPE_INV[i] * 0.15915494309189535; const float ph = (float)(rev - __builtin_floor(rev));
        ropeC[idx] = __builtin_amdgcn_cosf(ph); ropeS[idx] = __builtin_amdgcn_sinf(ph); }
    {
        f32x4 g[4];
#pragma unroll
        for (int j = 0; j < 4; ++j) g[j] = *((const f32x4*)AR.in[4] + F.lane + 64 * j);
        for (int m = gw; m < T; m += NGW) rms_row_to_bf16(m < TP ? AR.in[0] + (size_t)m * DM : AR.in[1] + (size_t)(m - TP) * DM, g, XN + (size_t)m * DM, F.lane);
#pragma unroll
        for (int j = 0; j < 4; ++j) g[j] = *((const f32x4*)AR.in[13] + F.lane + 64 * j);
        for (int m = gw; m < TMEM; m += NGW) rms_row_to_bf16(m < TMP ? AR.in[2] + (size_t)m * DM : AR.in[3] + (size_t)(m - TMP) * DM, g, MN + (size_t)m * DM, F.lane);
    }
}

__device__ __forceinline__ void final_norm(Frame& F, const Args& AR) {
    const float* PS = (const float*)(F.ws + WS_PS);
    const int gw = F.vcu * NWAVES + F.wave, NGW = F.G * NWAVES;
    f32x4 g[4];
#pragma unroll
    for (int j = 0; j < 4; ++j) g[j] = *((const f32x4*)AR.in[20] + F.lane + 64 * j);
    for (int m = gw; m < T; m += NGW) {
        const float pv = (F.lane < 16) ? PS[(size_t)m * 16 + F.lane] : 0.f;
        const float r = __builtin_amdgcn_rsqf(wave_sum(pv) * (1.f / DM) + EPS);
        f32x4* xr = (f32x4*)(F.out + (size_t)m * DM) + F.lane;
#pragma unroll
        for (int j = 0; j < 4; ++j) xr[64 * j] = xr[64 * j] * g[j] * r;
    }
}

constexpr int NSTEPS = 12;
__global__ void __launch_bounds__(NWAVES * 64, 2) fwd_kernel(Args args) {
    extern __shared__ __attribute__((aligned(16))) unsigned char lds_raw[];
    Frame F;
    F.lds = (LAS unsigned char*)lds_raw;
    F.tid = threadIdx.x; F.lane = F.tid & 63; F.wave = __builtin_amdgcn_readfirstlane(F.tid >> 6);
    F.G = GRID; { const int bx = blockIdx.x; F.vcu = (bx % 8) * (GRID / 8) + bx / 8; }
    F.out = args.out; F.ws = args.ws;
    volatile LAS unsigned* MISC = (volatile LAS unsigned*)(F.lds + MISC_OFF);
    if (F.tid < 32) MISC[F.tid] = 0u;
    __syncthreads();
    unsigned* ctl = (unsigned*)(F.ws + WS_CTL);
    XcdBarrier bar; bar.bar = ctl + CW_BAR; bar.x = 0; bar.st = nullptr;
    const int lo = args.st_lo, hi = args.st_hi;
    if (hi - lo > 1) bar = xcd_barrier_post(ctl + CW_BAR, MISC + 8);
#ifndef PH_MASK
#define PH_MASK 0xfff
#endif
#define IN(k) (((PH_MASK >> (k)) & 1) && lo <= (k) && (k) < hi)
#define SEAM(k) do { if (IN(k) && IN((k) + 1)) xcd_barrier(bar); } while (0)
#define MIB(x) ((int)((x) / MiB))
    unsigned char* ws = F.ws; unsigned char* dob = (unsigned char*)F.out;
    Epi E; E.ws = ws; E.out = F.out; E.xp = nullptr; E.xs = nullptr;
    if (IN(0)) { p0_prologue(F, args); } SEAM(0);
    if (IN(1)) { Sched<SK_P1, 0, 1024, 1024> S{(const char*)ws, (const char*)dob}; gemm_phase<SK_P1, 0, 1024, 1024, 1024, EK_P1, 0>(F.lds, S, E); } SEAM(1);
    if (IN(2)) {
        { Sched<SK_GEN, 3, ZW, QL> S{(const char*)(dob + DO_Z), (const char*)(ws + WS_WUQT)}; gemm_phase<SK_GEN, 3, ZW, QL, QL, EK_Q, 0>(F.lds, S, E); }
        { Sched<SK_GEN, 4, ZW, KVL> S{(const char*)(dob + DO_Z) + QL * 2, (const char*)(ws + WS_WUKVT)}; gemm_phase<SK_GEN, 4, ZW, KVL, KVL, EK_KV, 0>(F.lds, S, E); }
    } SEAM(2);
    if (IN(3)) {
        { Sched<SK_DFT, 0, 4096, 4096> S{(const char*)(ws + WS_DFTM), (const char*)(ws + WS_R1)}; gemm_phase<SK_DFT, 0, 4096, 4096, 4096, EK_DFT, MIB(WS_R0)>(F.lds, S, E); }
        const int c = (int)blockIdx.x, x = c & 7, j = c >> 3;
        const int nun = (j < 24) ? 5 : 9;
        const bf16_t* Qb = (const bf16_t*)(dob + DO_Q); const bf16_t* Kfb = (const bf16_t*)(ws + WS_KF); const bf16_t* Vb = (const bf16_t*)(ws + WS_V); bf16_t* Y = (bf16_t*)(ws + WS_R0);
        for (int r = 0; r < nun; ++r) {
            const int uidx = (j < 24) ? (72 + j + 24 * r) : ((j - 24) + 8 * r);
            const int bh = x * 24 + (uidx >> 3), qb = uidx & 7, b = bh >> 3, h = bh & 7;
            const size_t row0 = (size_t)b * SEQ;
            mla::attn_unit(Qb + (row0 + qb * 256) * 768 + h * DQK, Kfb + row0 * 768 + h * DQK, Vb + row0 * 512 + h * DVH, Y + (row0 + qb * 256) * 1024 + h * DVH, (char*)lds_raw);
        }
    } SEAM(3);
    if (IN(4)) { Epi E4 = E; E4.xp = args.in[0]; E4.xs = args.in[1];
        Sched<SK_GEN, 4, 1024, 1024> S{(const char*)(ws + WS_R0), (const char*)(ws + WS_WOUTT)}; gemm_phase<SK_GEN, 4, 1024, 1024, 1024, EK_RES_X, MIB(WS_R1)>(F.lds, S, E4); } SEAM(4);
    if (IN(5)) { Sched<SK_GEN, 4, 1024, 1024> S{(const char*)(ws + WS_R1), (const char*)(ws + WS_WXQT)}; gemm_phase<SK_GEN, 4, 1024, 1024, 1024, EK_ROWSCALE, MIB(WS_R0)>(F.lds, S, E); } SEAM(5);
    if (IN(6)) { Sched<SK_XS, 4, 1024, 1024> S{(const char*)(ws + WS_R0), (const char*)(ws + WS_KX)}; gemm_phase<SK_XS, 4, 1024, 1024, 256, EK_SOFTMAX, MIB(WS_R1)>(F.lds, S, E); } SEAM(6);
    if (IN(7)) { Sched<SK_XPV, 4, 1024, 256> S{(const char*)(ws + WS_R1), (const char*)(ws + WS_VXT)}; gemm_phase<SK_XPV, 4, 1024, 256, 256, EK_PLAIN, MIB(WS_R0)>(F.lds, S, E); } SEAM(7);
    if (IN(8)) { Sched<SK_GEN, 4, 1024, 1024> S{(const char*)(ws + WS_R0), (const char*)(ws + WS_WXOT)}; gemm_phase<SK_GEN, 4, 1024, 1024, 1024, EK_RES, MIB(WS_R1)>(F.lds, S, E); } SEAM(8);
    if (IN(9)) { Sched<SK_GEN, 22, 1024, 1024> S{(const char*)(ws + WS_R1), (const char*)(ws + WS_WGUT)}; gemm_phase<SK_GEN, 22, 1024, 1024, 1024, EK_SWIGLU, MIB(WS_H)>(F.lds, S, E); } SEAM(9);
    if (IN(10)) { Sched<SK_GEN, 4, DFF, DFF> S{(const char*)(ws + WS_H), (const char*)(ws + WS_WDT)}; gemm_phase<SK_GEN, 4, DFF, DFF, DFF, EK_RES_NOB, 0>(F.lds, S, E); } SEAM(10);
    if (IN(11)) { final_norm(F, args); }
#undef IN
#undef SEAM
#undef MIB
}

extern "C" void kernel_launch(void* const* d_in, const int* in_sizes, int n_in, void* d_out, int out_size, void* d_ws, size_t ws_size, hipStream_t stream) {
    static int grid = 0;
    if (grid == 0) {
        if (n_in != 21 || in_sizes[0] != TP * DM || in_sizes[1] != (T - TP) * DM || out_size != T * DM || ws_size < WS_END) {
            fprintf(stderr, "kernel_launch: unexpected shapes (n_in %d, in0 %d, out %d, ws %zu); nothing launched\n", n_in, n_in > 0 ? in_sizes[0] : -1, out_size, ws_size); grid = -1; return; }
        int dev = 0, cus = 0, per_cu = 0;
        if (hipGetDevice(&dev) != hipSuccess || hipDeviceGetAttribute(&cus, hipDeviceAttributeMultiprocessorCount, dev) != hipSuccess) { grid = -1; return; }
        if (hipFuncSetAttribute((const void*)fwd_kernel, hipFuncAttributeMaxDynamicSharedMemorySize, LDS_BYTES) != hipSuccess) { fprintf(stderr, "kernel_launch: hipFuncSetAttribute failed\n"); grid = -1; return; }
        if (hipOccupancyMaxActiveBlocksPerMultiprocessor(&per_cu, (const void*)fwd_kernel, NWAVES * 64, LDS_BYTES) != hipSuccess || per_cu < 1) { fprintf(stderr, "kernel_launch: occupancy query says %d blocks/CU\n", per_cu); grid = -1; (void)hipGetLastError(); return; }
        (void)hipGetLastError();
        if (cus != 256) { fprintf(stderr, "kernel_launch: built for 256 CUs, device has %d\n", cus); grid = -1; return; }
        grid = cus;
    }
    if (grid < 0) return;
    (void)hipMemsetAsync((char*)d_ws + WS_CTL, 0, CTL_ZERO_BYTES, stream);
    Args a{};
    for (int i = 0; i < 21; ++i) a.in[i] = (const float*)d_in[i];
    a.out = (float*)d_out; a.ws = (unsigned char*)d_ws;
#if DBG_STEPS
    for (int st = 0; st < NSTEPS; ++st) { a.st_lo = st; a.st_hi = st + 1; hipLaunchKernelGGL(fwd_kernel, dim3(grid), dim3(NWAVES * 64), LDS_BYTES, stream, a); }
#else
    a.st_lo = 0; a.st_hi = NSTEPS;
    hipLaunchKernelGGL(fwd_kernel, dim3(grid), dim3(NWAVES * 64), LDS_BYTES, stream, a);
#endif
}
```

```cpp
#include <hip/hip_runtime.h>
#include <cstdio>
#include <cstdint>

#define LAS __attribute__((address_space(3)))
#define GAS __attribute__((address_space(1)))
typedef unsigned short bf16_t;
typedef short bf16x8 __attribute__((ext_vector_type(8)));
typedef short s16x4 __attribute__((ext_vector_type(4)));
typedef float f32x4 __attribute__((ext_vector_type(4)));
typedef float f32x2 __attribute__((ext_vector_type(2)));
typedef float f32x16 __attribute__((ext_vector_type(16)));
typedef unsigned u32x4 __attribute__((ext_vector_type(4)));
typedef unsigned u32x2 __attribute__((ext_vector_type(2)));

#ifndef DBG_STEPS
#define DBG_STEPS 0
#endif

constexpr int DM = 1024, SEQ = 2048, NB = 24, NBP = 16, T = NB * SEQ, TP = NBP * SEQ;
constexpr int MEML = 256, TMEM = NB * MEML, TMP = NBP * MEML;
constexpr int QL = 384, KVL = 256, DR = 32, FW = 512, INW = 1184;
constexpr int NH = 8, DN = 64, DVH = 64, DQK = 96;
constexpr int ZW = 768;
constexpr int DFF = 2816;
constexpr float EPS = 1e-6f;
constexpr float LOG2E = 1.4426950408889634f;
constexpr float QSCALE = 0.10206207261596577f * LOG2E;
constexpr float XSCALE = 0.0625f * LOG2E;

constexpr size_t MiB = 1u << 20;
constexpr size_t WS_CTL = 0, CTL_ZERO_BYTES = 65536;
constexpr size_t WS_WZT = 1 * MiB, WS_WFT = 3 * MiB, WS_WXKT = 5 * MiB, WS_WXVT = 7 * MiB, WS_WUQT = 9 * MiB, WS_WUKVT = 10 * MiB;
constexpr size_t WS_ROPEC = 11 * MiB, WS_ROPES = 11 * MiB + 128 * 1024;
constexpr size_t WS_DFTM = 12 * MiB, WS_WOUTT = 28 * MiB, WS_WXQT = 30 * MiB, WS_WXOT = 32 * MiB, WS_WGUT = 34 * MiB, WS_WDT = 45 * MiB;
constexpr size_t WS_R0 = 52 * MiB;
constexpr size_t WS_R1 = 148 * MiB;
constexpr size_t WS_R2 = 244 * MiB;
constexpr size_t WS_KF = WS_R2, WS_V = WS_R2 + 72 * MiB, WS_KX = WS_R2 + 120 * MiB, WS_VXT = WS_R2 + 132 * MiB, WS_H = WS_R2;
constexpr size_t WS_PS = 508 * MiB;
constexpr size_t WS_END = 511 * MiB;
constexpr size_t DO_Z = 0, DO_MN = 72 * MiB, DO_PS1 = 84 * MiB, DO_Q = 96 * MiB;
constexpr int CW_BAR = 4096;

__device__ __forceinline__ unsigned cvt_pk_bf16(float lo, float hi) { unsigned r; asm volatile("v_cvt_pk_bf16_f32 %0, %1, %2" : "=v"(r) : "v"(lo), "v"(hi)); return r; }
__device__ __forceinline__ u32x4 pack8(f32x4 a, f32x4 b) { u32x4 w; w.x = cvt_pk_bf16(a[0], a[1]); w.y = cvt_pk_bf16(a[2], a[3]); w.z = cvt_pk_bf16(b[0], b[1]); w.w = cvt_pk_bf16(b[2], b[3]); return w; }
__device__ __forceinline__ float bf2f(bf16_t v) { return __uint_as_float(((unsigned)v) << 16); }
__device__ __forceinline__ float sumsq8(f32x4 a, f32x4 b) { return (a[0] * a[0] + a[1] * a[1]) + (a[2] * a[2] + a[3] * a[3]) + (b[0] * b[0] + b[1] * b[1]) + (b[2] * b[2] + b[3] * b[3]); }
__device__ __forceinline__ float fq_sum(float v) { v += __shfl_xor(v, 16); v += __shfl_xor(v, 32); return v; }
__device__ __forceinline__ float fq_max(float v) { v = fmaxf(v, __shfl_xor(v, 16)); v = fmaxf(v, __shfl_xor(v, 32)); return v; }
__device__ __forceinline__ float wave_sum(float v) {
#pragma unroll
    for (int o = 1; o < 64; o <<= 1) v += __shfl_xor(v, o);
    return v;
}
#define LDS_WAIT() asm volatile("s_waitcnt lgkmcnt(0)" ::: "memory")
#define VM_WAIT() asm volatile("s_waitcnt vmcnt(0)" ::: "memory")

namespace pg8 {
constexpr int BM = 256, BK = 64, HALF = 128, HTB = HALF * BK * 2, STAGE_BYTES = 8 * HTB;
__host__ __device__ __forceinline__ int lds_byte(int r, int c) { const int st = (r >> 4) * 2 + (c >> 5), rr = r & 15, cc = c & 31, ob = rr * 64 + cc * 2; return st * 1024 + (ob ^ (((ob >> 9) & 1) << 5)); }
__host__ __device__ __forceinline__ void stage_rc(int b, int& R, int& C) { const int st = b / 1024, sb = b % 1024, swz = sb ^ (((sb >> 9) & 1) << 5); R = (st >> 1) * 16 + swz / 64; C = (st & 1) * 32 + (swz % 64) / 2; }
__host__ __device__ __forceinline__ int perm32(int rho) { const int n = rho >> 4, i = rho & 15; return 8 * (i >> 2) + 4 * n + (i & 3); }
struct Unit { int pm, pn, ty; const char* a; const char* b; };
}
using pg8::Unit;

enum { SK_GEN = 0, SK_P1 = 1, SK_XS = 2, SK_XPV = 3, SK_DFT = 4 };
constexpr int GRID = 256;
__device__ __forceinline__ bool tile_of(int L, int nM, int nN, int& pm, int& pn) {
    const int nwg = nM * nN; if (L >= nwg || L < 0) return false;
    const int q = nwg / 8, r = nwg % 8, xcd = L % 8, off = L / 8;
    const int wgid = (xcd < r ? xcd * (q + 1) : r * (q + 1) + (xcd - r) * q) + off;
    const int nig = 8 * nN, gid = wgid / nig, fm = gid * 8, gsz = (nM - fm) < 8 ? (nM - fm) : 8;
    pm = fm + ((wgid % nig) % gsz); pn = (wgid % nig) / gsz; return true;
}
template <int KIND, int NN, int LDA, int LDB>
struct Sched {
    const char* A; const char* B;
    __device__ __forceinline__ bool next(int i, Unit& u) const {
        const int c = (int)blockIdx.x; const int L = i * GRID + c;
        u.ty = 0;
        if constexpr (KIND == SK_GEN) {
            if (!tile_of(L, 192, NN, u.pm, u.pn)) return false;
            u.a = A + (size_t)u.pm * ((size_t)512 * LDA); u.b = B + (size_t)u.pn * ((size_t)512 * LDB); return true;
        } else if constexpr (KIND == SK_P1) {
            constexpr size_t TS = (size_t)256 * 1024 * 2; const char* ws = A; const char* dob = B;
            if (L < 768) { tile_of(L, 4, 192, u.pm, u.pn); u.ty = 0; u.a = ws + WS_WFT + u.pm * TS; u.b = ws + WS_R0 + u.pn * TS; return true; }
            if (L < 1344) { tile_of(L - 768, 192, 3, u.pm, u.pn); u.ty = 1; u.a = ws + WS_R0 + u.pm * TS; u.b = ws + WS_WZT + u.pn * TS; return true; }
            if (L < 1440) { tile_of(L - 1344, 24, 4, u.pm, u.pn); u.ty = 2; u.a = dob + DO_MN + u.pm * TS; u.b = ws + WS_WXKT + u.pn * TS; return true; }
            if (L < 1536) { tile_of(L - 1440, 4, 24, u.pm, u.pn); u.ty = 3; u.a = ws + WS_WXVT + u.pm * TS; u.b = dob + DO_MN + u.pn * TS; return true; }
            return false;
        } else if constexpr (KIND == SK_XS) {
            if (!tile_of(L, 192, 4, u.pm, u.pn)) return false;
            u.a = A + (size_t)u.pm * ((size_t)512 * 1024) + (size_t)u.pn * 512; u.b = B + (size_t)(u.pm >> 3) * ((size_t)256 * 2048) + (size_t)u.pn * 512; return true;
        } else if constexpr (KIND == SK_XPV) {
            if (!tile_of(L, 192, 4, u.pm, u.pn)) return false;
            u.a = A + (size_t)u.pm * ((size_t)512 * 1024) + (size_t)u.pn * 512; u.b = B + (size_t)((u.pm >> 3) * 4 + u.pn) * 131072; return true;
        } else {
            const int x = c & 7, j = c >> 3; if (j >= 24 || i >= 2) return false;
            const int w = j + 24 * i, bb = 3 * x + (w >> 4); u.pm = (w & 15) & 7; u.pn = (w & 15) >> 3; u.ty = bb;
            u.a = A + (size_t)u.pm * ((size_t)256 * 4096 * 2); u.b = B + ((size_t)(bb * 512 + u.pn * 256)) * 4096 * 2; return true;
        }
    }
};

enum { EK_P1 = 0, EK_Q, EK_KV, EK_DFT, EK_RES_X, EK_RES, EK_RES_NOB, EK_ROWSCALE, EK_SOFTMAX, EK_PLAIN, EK_SWIGLU };
struct Epi { unsigned char* ws; float* out; const float* xp; const float* xs; };
constexpr int LDS_SMX = 131072;

__device__ __forceinline__ float row_r16(const float* PS, int row, int fq) {
    const f32x4 p = *(const f32x4*)(PS + (size_t)row * 16 + fq * 4);
    const float tot = fq_sum((p[0] + p[1]) + (p[2] + p[3]));
    return __builtin_amdgcn_rsqf(tot * (1.0f / 1024.0f) + EPS);
}
__device__ __forceinline__ void rope8(f32x4& v0, f32x4& v1, const f32x4 cs4, const f32x4 sn4) {
    f32x4 o0, o1;
    o0[0] = v0[0] * cs4[0] - v0[1] * sn4[0]; o0[1] = v0[1] * cs4[0] + v0[0] * sn4[0];
    o0[2] = v0[2] * cs4[1] - v0[3] * sn4[1]; o0[3] = v0[3] * cs4[1] + v0[2] * sn4[1];
    o1[0] = v1[0] * cs4[2] - v1[1] * sn4[2]; o1[1] = v1[1] * cs4[2] + v1[0] * sn4[2];
    o1[2] = v1[2] * cs4[3] - v1[3] * sn4[3]; o1[3] = v1[3] * cs4[3] + v1[2] * sn4[3];
    v0 = o0; v1 = o1;
}
#define EPI_ARGS const Epi& E, f32x4 (&acc)[2][2][4][2], const Unit& u, int wr, int wc, int fr, int fq, LAS unsigned char* lds
#define EPI_ROWS for (int ai = 0; ai < 2; ++ai) _Pragma("unroll") for (int m = 0; m < 4; ++m)
#define EPI_FENCE() asm volatile("" ::: "memory")

__device__ __forceinline__ void epi_p1(EPI_ARGS) {
    const int rl0 = wr * 64 + fr, cl0 = wc * 32 + 8 * fq;
    if (u.ty == 0) {
        bf16_t* UT2 = (bf16_t*)(E.ws + WS_R1);
#pragma unroll
        EPI_ROWS { const int R = u.pm * 256 + ai * 128 + m * 16 + rl0; const int g = R >> 8, cs = (R >> 7) & 1, j = R & 127;
#pragma unroll
            for (int bj = 0; bj < 2; ++bj) { const int t = u.pn * 256 + bj * 128 + cl0; const int b = t >> 11, s = t & 2047;
                *(u32x4*)(UT2 + ((size_t)(b * 512 + g * 128 + j)) * 4096 + cs * 2048 + s) = pack8(acc[ai][bj][m][0], acc[ai][bj][m][1]); } }
    } else if (u.ty == 1) {
        bf16_t* Z = (bf16_t*)((unsigned char*)E.out + DO_Z); float* PS1 = (float*)((unsigned char*)E.out + DO_PS1); bf16_t* Kf = (bf16_t*)(E.ws + WS_KF);
        const float* ropeC = (const float*)(E.ws + WS_ROPEC); const float* ropeS = (const float*)(E.ws + WS_ROPES);
#pragma unroll
        EPI_ROWS { const int row = u.pm * 256 + ai * 128 + m * 16 + rl0;
#pragma unroll
            for (int bj = 0; bj < 2; ++bj) { const int c = u.pn * 256 + bj * 128 + cl0; f32x4 v0 = acc[ai][bj][m][0], v1 = acc[ai][bj][m][1];
                *(u32x4*)(Z + (size_t)row * ZW + c) = pack8(v0, v1);
                const float ss = fq_sum(sumsq8(v0, v1)); const int half = u.pn * 2 + bj;
                if (half < 5 && fq == 0) PS1[(size_t)row * 24 + half * 4 + wc] = ss;
                if (half == 5 && wc == 0) {
                    const int pos = row & (SEQ - 1);
                    rope8(v0, v1, *(const f32x4*)(ropeC + pos * 16 + 4 * fq), *(const f32x4*)(ropeS + pos * 16 + 4 * fq));
                    const u32x4 w = pack8(v0, v1);
#pragma unroll
                    for (int h = 0; h < NH; ++h) *(u32x4*)(Kf + (size_t)row * 768 + h * DQK + DN + 8 * fq) = w;
                } } }
    } else if (u.ty == 2) {
        bf16_t* Kx = (bf16_t*)(E.ws + WS_KX);
#pragma unroll
        EPI_ROWS { const int row = u.pm * 256 + ai * 128 + m * 16 + rl0;
#pragma unroll
            for (int bj = 0; bj < 2; ++bj) *(u32x4*)(Kx + (size_t)row * 1024 + u.pn * 256 + bj * 128 + cl0) = pack8(acc[ai][bj][m][0], acc[ai][bj][m][1]); }
    } else {
        bf16_t* VxT = (bf16_t*)(E.ws + WS_VXT);
#pragma unroll
        EPI_ROWS { const int d = ai * 128 + m * 16 + rl0;
#pragma unroll
            for (int bj = 0; bj < 2; ++bj) *(u32x4*)(VxT + ((size_t)((u.pn * 4 + u.pm) * 256 + d)) * 256 + bj * 128 + cl0) = pack8(acc[ai][bj][m][0], acc[ai][bj][m][1]); }
    }
}
__device__ __forceinline__ void epi_q(EPI_ARGS) {
    const int rl0 = wr * 64 + fr, cl0 = wc * 32 + 8 * fq;
    const float* PS1 = (const float*)((unsigned char*)E.out + DO_PS1); bf16_t* Q = (bf16_t*)((unsigned char*)E.out + DO_Q);
    const float* ropeC = (const float*)(E.ws + WS_ROPEC); const float* ropeS = (const float*)(E.ws + WS_ROPES);
#pragma unroll
    EPI_ROWS { const int row = u.pm * 256 + ai * 128 + m * 16 + rl0; const int pos = row & (SEQ - 1);
        f32x4 p = {0.f, 0.f, 0.f, 0.f}; if (fq < 3) p = *(const f32x4*)(PS1 + (size_t)row * 24 + fq * 4);
        const float r = __builtin_amdgcn_rsqf(fq_sum((p[0] + p[1]) + (p[2] + p[3])) * (1.0f / QL) + EPS);
#pragma unroll
        for (int bj = 0; bj < 2; ++bj) { const int c = u.pn * 256 + bj * 128 + cl0; const int e = c % DQK;
            f32x4 v0 = acc[ai][bj][m][0] * r, v1 = acc[ai][bj][m][1] * r;
            if (e >= DN) { const int i0 = (e - DN) >> 1; rope8(v0, v1, *(const f32x4*)(ropeC + pos * 16 + i0), *(const f32x4*)(ropeS + pos * 16 + i0)); }
            *(u32x4*)(Q + (size_t)row * 768 + c) = pack8(v0, v1); }
        EPI_FENCE(); }
}
__device__ __forceinline__ void epi_kv(EPI_ARGS) {
    const int rl0 = wr * 64 + fr, cl0 = wc * 32 + 8 * fq;
    const float* PS1 = (const float*)((unsigned char*)E.out + DO_PS1); bf16_t* Kf = (bf16_t*)(E.ws + WS_KF); bf16_t* V = (bf16_t*)(E.ws + WS_V);
#pragma unroll
    EPI_ROWS { const int row = u.pm * 256 + ai * 128 + m * 16 + rl0;
        f32x4 p = {0.f, 0.f, 0.f, 0.f}; if (fq < 2) p = *(const f32x4*)(PS1 + (size_t)row * 24 + 12 + fq * 4);
        const float r = __builtin_amdgcn_rsqf(fq_sum((p[0] + p[1]) + (p[2] + p[3])) * (1.0f / KVL) + EPS);
#pragma unroll
        for (int bj = 0; bj < 2; ++bj) { const int c = u.pn * 256 + bj * 128 + cl0; const int h = c >> 7, e = c & 127;
            const u32x4 w = pack8(acc[ai][bj][m][0] * r, acc[ai][bj][m][1] * r);
            if (e < DN) *(u32x4*)(Kf + (size_t)row * 768 + h * DQK + e) = w; else *(u32x4*)(V + (size_t)row * 512 + h * DVH + (e - DN)) = w; }
        EPI_FENCE(); }
}
template <int OMIB> __device__ __forceinline__ void epi_plain(EPI_ARGS, int rowbase, int colbase) {
    const int rl0 = wr * 64 + fr, cl0 = wc * 32 + 8 * fq;
    bf16_t* O = (bf16_t*)(E.ws + (size_t)OMIB * MiB);
#pragma unroll
    EPI_ROWS { const int row = rowbase + ai * 128 + m * 16 + rl0;
#pragma unroll
        for (int bj = 0; bj < 2; ++bj) *(u32x4*)(O + (size_t)row * 1024 + colbase + bj * 128 + cl0) = pack8(acc[ai][bj][m][0], acc[ai][bj][m][1]); }
}
template <int EKIND, int OMIB> __device__ __forceinline__ void epi_res(EPI_ARGS) {
    const int rl0 = wr * 64 + fr, cl0 = wc * 32 + 8 * fq;
    bf16_t* XB = (bf16_t*)(E.ws + WS_R1); float* PS = (float*)(E.ws + WS_PS);
#pragma unroll
    EPI_ROWS { const int row = u.pm * 256 + ai * 128 + m * 16 + rl0;
        float ss = 0.f;
#pragma unroll
        for (int bj = 0; bj < 2; ++bj) { const int c = u.pn * 256 + bj * 128 + cl0;
            f32x4 y0, y1;
            if constexpr (EKIND == EK_RES_X) { const float* rs = (row < TP ? E.xp + (size_t)row * DM : E.xs + (size_t)(row - TP) * DM); y0 = *(const f32x4*)(rs + c); y1 = *(const f32x4*)(rs + c + 4); }
            else { const u32x4 w = *(const u32x4*)(XB + (size_t)row * DM + c);
                y0 = (f32x4){__uint_as_float(w.x << 16), __uint_as_float(w.x & 0xffff0000u), __uint_as_float(w.y << 16), __uint_as_float(w.y & 0xffff0000u)};
                y1 = (f32x4){__uint_as_float(w.z << 16), __uint_as_float(w.z & 0xffff0000u), __uint_as_float(w.w << 16), __uint_as_float(w.w & 0xffff0000u)}; }
            y0 += acc[ai][bj][m][0]; y1 += acc[ai][bj][m][1];
            *(u32x4*)(XB + (size_t)row * DM + c) = pack8(y0, y1);
            ss += sumsq8(y0, y1); }
        ss = fq_sum(ss);
        if (fq == 0) PS[(size_t)row * 16 + u.pn * 4 + wc] = ss;
        EPI_FENCE(); }
}
template <int OMIB> __device__ __forceinline__ void epi_rowscale(EPI_ARGS) {
    const int rl0 = wr * 64 + fr, cl0 = wc * 32 + 8 * fq;
    bf16_t* O = (bf16_t*)(E.ws + (size_t)OMIB * MiB); const float* PS = (const float*)(E.ws + WS_PS);
#pragma unroll
    EPI_ROWS { const int row = u.pm * 256 + ai * 128 + m * 16 + rl0; const float r = row_r16(PS, row, fq);
#pragma unroll
        for (int bj = 0; bj < 2; ++bj) *(u32x4*)(O + (size_t)row * 1024 + u.pn * 256 + bj * 128 + cl0) = pack8(acc[ai][bj][m][0] * r, acc[ai][bj][m][1] * r);
        EPI_FENCE(); }
}
template <int OMIB> __device__ __forceinline__ void epi_swiglu(EPI_ARGS) {
    const int rl0 = wr * 64 + fr, cl0 = wc * 32 + 8 * fq;
    bf16_t* O = (bf16_t*)(E.ws + (size_t)OMIB * MiB); const float* PS = (const float*)(E.ws + WS_PS);
#pragma unroll
    EPI_ROWS { const int row = u.pm * 256 + ai * 128 + m * 16 + rl0; const float r = row_r16(PS, row, fq);
        f32x4 h[2];
#pragma unroll
        for (int n = 0; n < 2; ++n)
#pragma unroll
            for (int e = 0; e < 4; ++e) { const float g = acc[ai][0][m][n][e] * r, up = acc[ai][1][m][n][e] * r;
                h[n][e] = g * __builtin_amdgcn_rcpf(1.0f + __builtin_amdgcn_exp2f(-g * LOG2E)) * up; }
        *(u32x4*)(O + (size_t)row * DFF + u.pn * 128 + cl0) = pack8(h[0], h[1]);
        EPI_FENCE(); }
}
template <int OMIB> __device__ __forceinline__ void epi_softmax(EPI_ARGS) {
    const int rl0 = wr * 64 + fr, cl0 = wc * 32 + 8 * fq;
    bf16_t* O = (bf16_t*)(E.ws + (size_t)OMIB * MiB);
    LAS f32x2* TB = (LAS f32x2*)(lds + LDS_SMX);
    float mloc[2][4];
#pragma unroll
    EPI_ROWS {
        float mx = -3.0e38f;
#pragma unroll
        for (int bj = 0; bj < 2; ++bj)
#pragma unroll
            for (int n = 0; n < 2; ++n)
#pragma unroll
                for (int e = 0; e < 4; ++e) mx = fmaxf(mx, acc[ai][bj][m][n][e]);
        mx = fq_max(mx); float s = 0.f;
#pragma unroll
        for (int bj = 0; bj < 2; ++bj)
#pragma unroll
            for (int n = 0; n < 2; ++n)
#pragma unroll
                for (int e = 0; e < 4; ++e) { const float p = __builtin_amdgcn_exp2f(acc[ai][bj][m][n][e] - mx); acc[ai][bj][m][n][e] = p; s += p; }
        s = fq_sum(s); mloc[ai][m] = mx;
        if (fq == 0) TB[(ai * 128 + m * 16 + rl0) * 4 + wc] = (f32x2){mx, s};
    }
    LDS_WAIT(); __builtin_amdgcn_s_barrier(); asm volatile("" ::: "memory");
#pragma unroll
    EPI_ROWS { const int rl = ai * 128 + m * 16 + rl0; const int row = u.pm * 256 + rl;
        const f32x2 t0 = TB[rl * 4 + 0], t1 = TB[rl * 4 + 1], t2 = TB[rl * 4 + 2], t3 = TB[rl * 4 + 3];
        const float M = fmaxf(fmaxf(t0.x, t1.x), fmaxf(t2.x, t3.x));
        const float L = t0.y * __builtin_amdgcn_exp2f(t0.x - M) + t1.y * __builtin_amdgcn_exp2f(t1.x - M) + t2.y * __builtin_amdgcn_exp2f(t2.x - M) + t3.y * __builtin_amdgcn_exp2f(t3.x - M);
        const float f = __builtin_amdgcn_exp2f(mloc[ai][m] - M) * __builtin_amdgcn_rcpf(L);
#pragma unroll
        for (int bj = 0; bj < 2; ++bj) *(u32x4*)(O + (size_t)row * 1024 + u.pn * 256 + bj * 128 + cl0) = pack8(acc[ai][bj][m][0] * f, acc[ai][bj][m][1] * f); }
    LDS_WAIT(); __builtin_amdgcn_s_barrier(); asm volatile("" ::: "memory");
}
template <int EKIND, int OMIB> __device__ __forceinline__ void epilogue(EPI_ARGS) {
    if constexpr (EKIND == EK_P1) epi_p1(E, acc, u, wr, wc, fr, fq, lds);
    else if constexpr (EKIND == EK_Q) epi_q(E, acc, u, wr, wc, fr, fq, lds);
    else if constexpr (EKIND == EK_KV) epi_kv(E, acc, u, wr, wc, fr, fq, lds);
    else if constexpr (EKIND == EK_DFT) epi_plain<OMIB>(E, acc, u, wr, wc, fr, fq, lds, u.ty * SEQ + u.pm * 256, 512 + u.pn * 256);
    else if constexpr (EKIND == EK_RES || EKIND == EK_RES_X || EKIND == EK_RES_NOB) epi_res<EKIND, OMIB>(E, acc, u, wr, wc, fr, fq, lds);
    else if constexpr (EKIND == EK_ROWSCALE) epi_rowscale<OMIB>(E, acc, u, wr, wc, fr, fq, lds);
    else if constexpr (EKIND == EK_PLAIN) epi_plain<OMIB>(E, acc, u, wr, wc, fr, fq, lds, u.pm * 256, u.pn * 256);
    else if constexpr (EKIND == EK_SWIGLU) epi_swiglu<OMIB>(E, acc, u, wr, wc, fr, fq, lds);
    else epi_softmax<OMIB>(E, acc, u, wr, wc, fr, fq, lds);
}

template <int SKIND, int NN, int LDA, int LDB, int K, int EKIND, int OMIB>
__device__ __forceinline__ void gemm_phase(LAS unsigned char* lds, const Sched<SKIND, NN, LDA, LDB>& S, const Epi& E) {
    constexpr int lda = LDA, ldb = LDB;
    using namespace pg8;
    const int tid = threadIdx.x, wid = __builtin_amdgcn_readfirstlane(tid >> 6), lane = tid & 63, wr = wid >> 2, wc = wid & 3, fr = lane & 15, fq = lane >> 4;
    const int nt = K / BK;
    unsigned voffA[2], voffB[2];
#pragma unroll
    for (int i = 0; i < 2; ++i) { int R, C; stage_rc(tid * 16 + i * 8192, R, C); const int Rb = (R & ~31) + perm32(R & 31);
        voffA[i] = (unsigned)(R * lda + C) * 2u; voffB[i] = (unsigned)(Rb * ldb + C) * 2u; }
    const size_t kstep = (size_t)(BK * 2);
    const size_t hstepA = (size_t)HALF * lda * 2, hstepB = (size_t)HALF * ldb * 2;
    const unsigned ldsw = (unsigned)wid * 1024u;
    const int aoff = lds_byte(wr * 64 + fr, fq * 8), boff = lds_byte(wc * 32 + fr, fq * 8);
#define PG8_SA(b, h) (((b) * 2 + (h)) * HTB)
#define PG8_SB(b, h) ((4 + (b) * 2 + (h)) * HTB)
#define PG8_STAGE(bufoff, gbase, voff) do { _Pragma("unroll") for (int _i = 0; _i < 2; ++_i) \
        __builtin_amdgcn_global_load_lds((const unsigned*)((const char*)(gbase) + (voff)[_i]), (LAS unsigned*)(lds + (bufoff) + ldsw + _i * 8192), 16, 0, 0); } while (0)
#define PG8_LDA(dst, b, h) do { _Pragma("unroll") for (int m = 0; m < 4; ++m) _Pragma("unroll") for (int k = 0; k < 2; ++k) dst[m][k] = *(const LAS bf16x8*)(lds + PG8_SA(b, h) + aoff + m * 2048 + k * 1024); } while (0)
#define PG8_LDB(dst, b, h) do { _Pragma("unroll") for (int n = 0; n < 2; ++n) _Pragma("unroll") for (int k = 0; k < 2; ++k) dst[n][k] = *(const LAS bf16x8*)(lds + PG8_SB(b, h) + boff + n * 2048 + k * 1024); } while (0)
#define PG8_MMA(ai, bj, At, Bt) do { __builtin_amdgcn_s_setprio(1); _Pragma("unroll") for (int m = 0; m < 4; ++m) _Pragma("unroll") for (int n = 0; n < 2; ++n) _Pragma("unroll") for (int k = 0; k < 2; ++k) \
        acc[ai][bj][m][n] = __builtin_amdgcn_mfma_f32_16x16x32_bf16(Bt[n][k], At[m][k], acc[ai][bj][m][n], 0, 0, 0); __builtin_amdgcn_s_setprio(0); } while (0)
#define PG8_WAIT_V(n) asm volatile("s_waitcnt vmcnt(" #n ")" ::: "memory")
#define PG8_WAIT_L(n) asm volatile("s_waitcnt lgkmcnt(" #n ")" ::: "memory")
#define PG8_BAR __builtin_amdgcn_s_barrier()
#define PG8_SCHED __builtin_amdgcn_sched_barrier(0)
    Unit cur, nxt; int ui = 0;
    if (!S.next(0, cur)) return;
    f32x4 acc[2][2][4][2];
#pragma unroll
    for (int a = 0; a < 2; ++a)
#pragma unroll
        for (int b = 0; b < 2; ++b)
#pragma unroll
            for (int m = 0; m < 4; ++m)
#pragma unroll
                for (int n = 0; n < 2; ++n) acc[a][b][m][n] = (f32x4){0.f, 0.f, 0.f, 0.f};
    bf16x8 At[4][2], B0[2][2], B1[2][2];
    const char* cA = cur.a; const char* cB = cur.b;
    PG8_STAGE(PG8_SB(0, 0), cB, voffB); PG8_STAGE(PG8_SB(0, 1), cB + hstepB, voffB); PG8_STAGE(PG8_SA(0, 0), cA, voffA); PG8_STAGE(PG8_SA(0, 1), cA + hstepA, voffA);
    if (wr == 1) PG8_BAR;
    PG8_WAIT_V(2); PG8_BAR;
    PG8_STAGE(PG8_SB(1, 0), cB + kstep, voffB); PG8_STAGE(PG8_SA(1, 0), cA + kstep, voffA); PG8_STAGE(PG8_SB(1, 1), cB + hstepB + kstep, voffB);
    PG8_WAIT_V(6); PG8_BAR;
    for (;;) {
        const bool has_next = S.next(ui + 1, nxt);
        const char* nA = has_next ? nxt.a : cA; const char* nB = has_next ? nxt.b : cB;
#pragma unroll 1
        for (int t = 0; t < nt; t += 2) {
            const bool last = (t == nt - 2);
            const char* a1 = cA + (size_t)(t + 1) * kstep;
            const char* a2 = last ? nA : cA + (size_t)(t + 2) * kstep; const char* b2 = last ? nB : cB + (size_t)(t + 2) * kstep;
            const char* a3 = a2 + kstep; const char* b3 = b2 + kstep;
            PG8_LDB(B0, 0, 0); PG8_LDB(B1, 0, 1); PG8_SCHED; PG8_LDA(At, 0, 0); PG8_STAGE(PG8_SA(1, 1), a1 + hstepA, voffA);
            PG8_WAIT_V(8); PG8_WAIT_L(0); PG8_BAR; PG8_MMA(0, 0, At, B0); PG8_MMA(0, 1, At, B1); PG8_BAR; PG8_SCHED;
            PG8_LDA(At, 0, 1); PG8_STAGE(PG8_SB(0, 0), b2, voffB); PG8_STAGE(PG8_SB(0, 1), b2 + hstepB, voffB); PG8_STAGE(PG8_SA(0, 0), a2, voffA);
            PG8_WAIT_V(8); PG8_WAIT_L(0); PG8_BAR; PG8_MMA(1, 0, At, B0); PG8_MMA(1, 1, At, B1); PG8_BAR; PG8_SCHED;
            PG8_LDB(B0, 1, 0); PG8_LDB(B1, 1, 1); PG8_SCHED; PG8_LDA(At, 1, 0); PG8_STAGE(PG8_SA(0, 1), a2 + hstepA, voffA);
            PG8_WAIT_V(8); PG8_WAIT_L(0); PG8_BAR; PG8_MMA(0, 0, At, B0); PG8_MMA(0, 1, At, B1); PG8_BAR; PG8_SCHED;
            PG8_LDA(At, 1, 1); PG8_STAGE(PG8_SB(1, 0), b3, voffB); PG8_STAGE(PG8_SB(1, 1), b3 + hstepB, voffB); PG8_STAGE(PG8_SA(1, 0), a3, voffA);
            PG8_WAIT_V(8); PG8_WAIT_L(0); PG8_BAR; PG8_MMA(1, 0, At, B0); PG8_MMA(1, 1, At, B1); PG8_BAR; PG8_SCHED;
        }
        if (wr == 0) PG8_BAR;
        epilogue<EKIND, OMIB>(E, acc, cur, wr, wc, fr, fq, lds);
        if (!has_next) break;
#pragma unroll
        for (int a = 0; a < 2; ++a)
#pragma unroll
            for (int b = 0; b < 2; ++b)
#pragma unroll
                for (int m = 0; m < 4; ++m)
#pragma unroll
                    for (int n = 0; n < 2; ++n) acc[a][b][m][n] = (f32x4){0.f, 0.f, 0.f, 0.f};
        cur = nxt; cA = nA; cB = nB; ++ui;
        if (wr == 1) PG8_BAR;
    }
    PG8_WAIT_V(0);
    PG8_BAR;
#undef PG8_SA
#undef PG8_SB
#undef PG8_STAGE
#undef PG8_LDA
#undef PG8_LDB
#undef PG8_MMA
#undef PG8_WAIT_V
#undef PG8_WAIT_L
#undef PG8_BAR
#undef PG8_SCHED
}

namespace mla {
constexpr int NW = 8, QBLK = 32, KVBLK = 64;
constexpr int SHM_V = KVBLK * DVH * 2, SHM_K = KVBLK * 256;
constexpr int OFF_V = 0, OFF_K = 2 * SHM_V, OFF_WS = OFF_K + 2 * SHM_K, OFF_OST = OFF_WS + NW * 64 * 4, BYTES = OFF_OST + NW * 4096;
constexpr float THR = 11.5f;
#define KSWZ(row, colB) ((row) * 256 + ((colB) ^ (((row) & 7) << 4)))
#define SBAR() __builtin_amdgcn_sched_barrier(0)
__device__ __forceinline__ int crow(int r, int hi) { return (r & 3) + 8 * (r >> 2) + 4 * hi; }
__device__ __forceinline__ void partialSM(f32x16& p0, f32x16& p1, float& m_reg, float& mn, float& alpha) {
    float pmax = p0[0];
#pragma unroll
    for (int r = 1; r < 16; ++r) pmax = fmaxf(pmax, p0[r]);
#pragma unroll
    for (int r = 0; r < 16; ++r) pmax = fmaxf(pmax, p1[r]);
    { auto rr = __builtin_amdgcn_permlane32_swap(__float_as_uint(pmax), __float_as_uint(pmax), false, false); pmax = fmaxf(__uint_as_float(rr[0]), __uint_as_float(rr[1])); }
    if (__builtin_expect(__all(pmax - m_reg <= THR), 1)) { mn = m_reg; alpha = 1.f; }
    else { mn = fmaxf(m_reg, pmax); alpha = __builtin_amdgcn_exp2f(m_reg - mn); m_reg = mn; }
#pragma unroll
    for (int r = 0; r < 16; ++r) p0[r] = p0[r] - mn;
#pragma unroll
    for (int r = 0; r < 16; ++r) p1[r] = p1[r] - mn;
#pragma unroll
    for (int r = 0; r < 16; ++r) p0[r] = __builtin_amdgcn_exp2f(p0[r]);
}
__device__ __forceinline__ void finishSM(f32x16& p0, f32x16& p1, float alpha, float& l_reg, bf16x8& pa0, bf16x8& pa1, bf16x8& pa2, bf16x8& pa3) {
#pragma unroll
    for (int r = 0; r < 16; ++r) p1[r] = __builtin_amdgcn_exp2f(p1[r]);
    float ps = 0;
#pragma unroll
    for (int r = 0; r < 16; ++r) ps += p0[r];
#pragma unroll
    for (int r = 0; r < 16; ++r) ps += p1[r];
    { auto rr = __builtin_amdgcn_permlane32_swap(__float_as_uint(ps), __float_as_uint(ps), false, false); ps = __uint_as_float(rr[0]) + __uint_as_float(rr[1]); }
    l_reg = l_reg * alpha + ps;
#define PK4(P, BASE, OUT) do { unsigned a0 = cvt_pk_bf16(P[BASE + 0], P[BASE + 1]), a1 = cvt_pk_bf16(P[BASE + 2], P[BASE + 3]);   \
    unsigned b0 = cvt_pk_bf16(P[BASE + 4], P[BASE + 5]), b1 = cvt_pk_bf16(P[BASE + 6], P[BASE + 7]);                              \
    auto r0 = __builtin_amdgcn_permlane32_swap(a0, b0, false, false); auto r1 = __builtin_amdgcn_permlane32_swap(a1, b1, false, false); \
    u32x4 w = {r0[0], r1[0], r0[1], r1[1]}; OUT = *reinterpret_cast<bf16x8*>(&w); } while (0)
    PK4(p0, 0, pa0); PK4(p0, 8, pa1); PK4(p1, 0, pa2); PK4(p1, 8, pa3);
#undef PK4
}
__device__ __forceinline__ void qkt(f32x16& p0, f32x16& p1, const char* Ks, const bf16x8* qr, int r32, int hi) {
    p0 = f32x16{}; p1 = f32x16{};
#pragma unroll
    for (int d0 = 0; d0 < DQK / 16; ++d0) { const int cb = (d0 * 16 + hi * 8) * 2;
        const bf16x8 b0 = *reinterpret_cast<const bf16x8*>(Ks + KSWZ(r32, cb));
        const bf16x8 b1 = *reinterpret_cast<const bf16x8*>(Ks + KSWZ(32 + r32, cb));
        p0 = __builtin_amdgcn_mfma_f32_32x32x16_bf16(b0, qr[d0], p0, 0, 0, 0);
        p1 = __builtin_amdgcn_mfma_f32_32x32x16_bf16(b1, qr[d0], p1, 0, 0, 0); }
}
__device__ __forceinline__ int v_st(int k, int c) { const int kk = (k & ~0xC) | ((k & 4) << 1) | ((k & 8) >> 1); return ((kk >> 3) * 2 + (c >> 5)) * 512 + ((kk & 7) * 32 + (c & 31)) * 2; }
__device__ __forceinline__ int v_rd_base(int lane) { return ((lane & 3) << 3) | (((lane >> 2) & 3) << 6) | (((lane >> 4) & 1) << 5) | (((lane >> 5) & 1) << 8); }
constexpr int v_rd_off(int d0, int ks, int half) { return d0 * 512 + ks * 2048 + half * 1024; }
template <int OFF> __device__ __forceinline__ s16x4 tr_read(int vb) { s16x4 r; asm volatile("ds_read_b64_tr_b16 %0, %1 offset:%2" : "=&v"(r) : "v"(vb), "i"(OFF) : "memory"); return r; }
template <int D0> __device__ __forceinline__ void pv_one(f32x16& od, int vb, bf16x8 pa0, bf16x8 pa1, bf16x8 pa2, bf16x8 pa3) {
    const s16x4 l0 = tr_read<v_rd_off(D0, 0, 0)>(vb), h0 = tr_read<v_rd_off(D0, 0, 1)>(vb), l1 = tr_read<v_rd_off(D0, 1, 0)>(vb), h1 = tr_read<v_rd_off(D0, 1, 1)>(vb);
    const s16x4 l2 = tr_read<v_rd_off(D0, 2, 0)>(vb), h2 = tr_read<v_rd_off(D0, 2, 1)>(vb), l3 = tr_read<v_rd_off(D0, 3, 0)>(vb), h3 = tr_read<v_rd_off(D0, 3, 1)>(vb);
    asm volatile("s_waitcnt lgkmcnt(0)" ::: "memory"); SBAR();
#define PK(L, H) (bf16x8){L[0], L[1], L[2], L[3], H[0], H[1], H[2], H[3]}
    od = __builtin_amdgcn_mfma_f32_32x32x16_bf16(pa0, PK(l0, h0), od, 0, 0, 0);
    od = __builtin_amdgcn_mfma_f32_32x32x16_bf16(pa1, PK(l1, h1), od, 0, 0, 0);
    od = __builtin_amdgcn_mfma_f32_32x32x16_bf16(pa2, PK(l2, h2), od, 0, 0, 0);
    od = __builtin_amdgcn_mfma_f32_32x32x16_bf16(pa3, PK(l3, h3), od, 0, 0, 0);
#undef PK
}
__device__ __forceinline__ void pv_d0(f32x16* o, int vb, bf16x8 pa0, bf16x8 pa1, bf16x8 pa2, bf16x8 pa3) {
    pv_one<0>(o[0], vb, pa0, pa1, pa2, pa3); pv_one<1>(o[1], vb, pa0, pa1, pa2, pa3);
}
__device__ __forceinline__ void attn_unit(const bf16_t* __restrict__ Qb, const bf16_t* __restrict__ Kh, const bf16_t* __restrict__ Vh, bf16_t* __restrict__ Ob, char* lds) {
    constexpr int LDQ = 768, LDK = 768, LDV = 512, LDO = 1024;
    const int tid = threadIdx.x, wid = tid >> 6, lane = tid & 63, r32 = lane & 31, hi = lane >> 5;
    char* V_lds = lds + OFF_V; char* K_lds = lds + OFF_K;
    float* ws = (float*)(lds + OFF_WS) + wid * 64; float* li_l = ws; float* al_l = ws + 32;
    float m_reg = -1e30f, l_reg = 0; f32x16 o[2] = {}; bf16x8 qr[DQK / 16];
    const bf16_t* Qw = Qb + (size_t)(wid * QBLK + r32) * LDQ + hi * 8;
#pragma unroll
    for (int d0 = 0; d0 < DQK / 16; ++d0) qr[d0] = *reinterpret_cast<const bf16x8*>(Qw + d0 * 16);
    const int vr = tid >> 3, vc = (tid & 7) * 8, vst = v_st(vr, vc);
    const int kr0 = tid >> 3, kc0 = (tid & 7) * 8, kst0 = KSWZ(kr0, kc0 * 2);
    const bool k1 = tid < 256; const int kr1 = (tid >> 2) & 63, kc1 = 64 + (tid & 3) * 8, kst1 = KSWZ(kr1, kc1 * 2);
    const int vb0 = (int)(uintptr_t)V_lds + v_rd_base(lane);
    struct { bf16x8 vs, ks0, ks1; } sr_[2];
#define SLOAD(i, k0) do { sr_[i].vs = *reinterpret_cast<const bf16x8*>(&Vh[(size_t)((k0) + vr) * LDV + vc]); \
    sr_[i].ks0 = *reinterpret_cast<const bf16x8*>(&Kh[(size_t)((k0) + kr0) * LDK + kc0]); \
    if (k1) sr_[i].ks1 = *reinterpret_cast<const bf16x8*>(&Kh[(size_t)((k0) + kr1) * LDK + kc1]); } while (0)
#define SWRITE(b, i) do { *(bf16x8*)(V_lds + (b) * SHM_V + vst) = sr_[i].vs; *(bf16x8*)(K_lds + (b) * SHM_K + kst0) = sr_[i].ks0; \
    if (k1) *(bf16x8*)(K_lds + (b) * SHM_K + kst1) = sr_[i].ks1; } while (0)
#define RESC(a) do { if (__any((a) < 1.f)) { if (hi == 0) al_l[r32] = (a); asm volatile("s_waitcnt lgkmcnt(0)" ::: "memory"); \
    _Pragma("unroll") for (int d = 0; d < 2; ++d) _Pragma("unroll") for (int r = 0; r < 16; ++r) o[d][r] *= al_l[crow(r, hi)]; } } while (0)
    f32x16 pA0, pA1, pB0, pB1; float mnA, mnB, alA, alB; bf16x8 pa0, pa1, pa2, pa3; constexpr int NT = SEQ / KVBLK;
    constexpr int SE = 0, SO = 1;
    SLOAD(SE, 0); asm volatile("s_waitcnt vmcnt(0)" ::: "memory"); SWRITE(0, SE); __syncthreads();
    qkt(pA0, pA1, K_lds, qr, r32, hi); partialSM(pA0, pA1, m_reg, mnA, alA);
    SLOAD(SO, KVBLK); SLOAD(SE, 2 * KVBLK);
    SWRITE(1, SO); __syncthreads();
    for (int j = 1; j + 1 < NT; j += 2) {
        SBAR(); qkt(pB0, pB1, K_lds + SHM_K, qr, r32, hi);
        finishSM(pA0, pA1, alA, l_reg, pa0, pa1, pa2, pa3); SBAR();
        SLOAD(SO, (j + 2) * KVBLK); SBAR();
        pv_d0(o, vb0, pa0, pa1, pa2, pa3); partialSM(pB0, pB1, m_reg, mnB, alB);
        __syncthreads(); SWRITE(0, SE);
        RESC(alB); __syncthreads();
        SBAR(); qkt(pA0, pA1, K_lds, qr, r32, hi);
        finishSM(pB0, pB1, alB, l_reg, pa0, pa1, pa2, pa3); SBAR();
        if (j + 3 < NT) SLOAD(SE, (j + 3) * KVBLK); SBAR();
        pv_d0(o, vb0 + SHM_V, pa0, pa1, pa2, pa3); partialSM(pA0, pA1, m_reg, mnA, alA);
        __syncthreads(); SWRITE(1, SO);
        RESC(alA); __syncthreads();
    }
    SBAR(); qkt(pB0, pB1, K_lds + SHM_K, qr, r32, hi);
    finishSM(pA0, pA1, alA, l_reg, pa0, pa1, pa2, pa3); SBAR();
    pv_d0(o, vb0, pa0, pa1, pa2, pa3); partialSM(pB0, pB1, m_reg, mnB, alB);
    __syncthreads(); RESC(alB);
    finishSM(pB0, pB1, alB, l_reg, pa0, pa1, pa2, pa3); SBAR();
    pv_d0(o, vb0 + SHM_V, pa0, pa1, pa2, pa3);
    if (hi == 0) li_l[r32] = l_reg; asm volatile("s_waitcnt lgkmcnt(0)" ::: "memory");
    float rli[16];
#pragma unroll
    for (int r = 0; r < 16; ++r) rli[r] = __builtin_amdgcn_rcpf(li_l[crow(r, hi)]);
    {
        bf16_t* stg = (bf16_t*)(lds + OFF_OST) + wid * 2048;
#pragma unroll
        for (int r = 0; r < 16; ++r) { const int orow = crow(r, hi);
#pragma unroll
            for (int d0 = 0; d0 < 2; ++d0) stg[orow * 64 + d0 * 32 + r32] = (bf16_t)(cvt_pk_bf16(o[d0][r] * rli[r], 0.f) & 0xffffu); }
        asm volatile("s_waitcnt lgkmcnt(0)" ::: "memory");
        bf16_t* Ow = Ob + (size_t)(wid * QBLK) * LDO;
#pragma unroll
        for (int i = 0; i < 4; ++i) { const int row = i * 8 + (lane >> 3), ch = lane & 7; const u32x4 v = *(const u32x4*)(stg + row * 64 + ch * 8); *(u32x4*)(Ow + (size_t)row * LDO + ch * 8) = v; }
    }
    __syncthreads();
#undef SLOAD
#undef SWRITE
#undef RESC
}
#undef KSWZ
#undef SBAR
}

#define XB_TMO      128
#define XB_XCNT(j)  (256  + 64 * (j))
#define XB_XSUB(j)  (1280 + 64 * (j))
#define XB_XGEN(j)  (2304 + 64 * (j))
#define XB_TOP      3328
#define XB_TOPGEN   3392
#define XCD_BAR_WORDS 3456
#define XB_SPIN_CAP (1u << 18)
__device__ __forceinline__ unsigned xb_ld(unsigned* p)              { return __hip_atomic_load(p, __ATOMIC_RELAXED, __HIP_MEMORY_SCOPE_AGENT); }
__device__ __forceinline__ unsigned xb_add(unsigned* p, unsigned v) { return __hip_atomic_fetch_add(p, v, __ATOMIC_RELAXED, __HIP_MEMORY_SCOPE_AGENT); }
__device__ __forceinline__ unsigned xb_xcc_id() { return (unsigned)__builtin_amdgcn_s_getreg((3 << 11) | 20) & 0xFu; }
#define XB_SPIN(cond, bar) do { unsigned _sp = 0; while (cond) { __builtin_amdgcn_s_sleep(1); \
    if ((++_sp & 255u) == 0u) { if (xb_ld(&(bar)[XB_TMO])) break; if (_sp > XB_SPIN_CAP) { atomicAdd(&(bar)[XB_TMO], 1u); break; } } } } while (0)
struct XcdBarrier { unsigned* bar; unsigned x; volatile LAS unsigned* st; };
__device__ __forceinline__ XcdBarrier xcd_barrier_post(unsigned* bar, volatile LAS unsigned* st) {
    XcdBarrier b; b.bar = bar; b.x = xb_xcc_id(); b.st = st;
    if (threadIdx.x == 0) (void)xb_add(&bar[XB_XCNT(b.x)], 1u);
    return b;
}
__device__ __forceinline__ void xcd_barrier_complete(unsigned* bar, unsigned x, unsigned& nloc, unsigned& nx) {
    const unsigned G = gridDim.x * gridDim.y * gridDim.z;
    unsigned sum, cnt, mine, sp = 0u;
    for (;;) {
        sum = 0u; cnt = 0u; mine = 0u;
#pragma unroll
        for (unsigned j = 0; j < 16; ++j) { const unsigned c = xb_ld(&bar[XB_XCNT(j)]); sum += c; cnt += (c > 0u) ? 1u : 0u; mine = (j == x) ? c : mine; }
        if (sum == G) break;
        __builtin_amdgcn_s_sleep(1);
        if ((++sp & 255u) == 0u) { if (xb_ld(&bar[XB_TMO])) break; if (sp > XB_SPIN_CAP) { atomicAdd(&bar[XB_TMO], 1u); break; } }
    }
    nloc = mine > 0u ? mine : 1u; nx = cnt > 0u ? cnt : 1u;
}
__device__ __forceinline__ void xcd_barrier(const XcdBarrier& b) {
    asm volatile("s_waitcnt vmcnt(0)" ::: "memory");
    __syncthreads();
    if (threadIdx.x == 0) {
        unsigned* bar = b.bar;
        __builtin_amdgcn_s_waitcnt(0);
        unsigned nloc = b.st[0], nx = b.st[1];
        if (nloc == 0u) { xcd_barrier_complete(bar, b.x, nloc, nx); b.st[0] = nloc; b.st[1] = nx; }
        const unsigned old = xb_add(&bar[XB_XSUB(b.x)], 1u);
        const unsigned gen = old / nloc;
        if (old + 1u == (gen + 1u) * nloc) {
            __builtin_amdgcn_fence(__ATOMIC_RELEASE, "agent");
            asm volatile("s_waitcnt vmcnt(0)" ::: "memory");
            const unsigned og = xb_add(&bar[XB_TOP], 1u);
            const unsigned tg = og / nx;
            if (og + 1u == (tg + 1u) * nx) xb_add(&bar[XB_TOPGEN], 1u);
            else XB_SPIN(xb_ld(&bar[XB_TOPGEN]) == tg, bar);
            __builtin_amdgcn_fence(__ATOMIC_ACQUIRE, "agent");
            xb_add(&bar[XB_XGEN(b.x)], 1u);
            asm volatile("s_waitcnt vmcnt(0)" ::: "memory");
        } else {
            XB_SPIN(xb_ld(&bar[XB_XGEN(b.x)]) == gen, bar);
            __builtin_amdgcn_fence(__ATOMIC_ACQUIRE, "agent");
            asm volatile("s_waitcnt vmcnt(0)" ::: "memory");
        }
    }
    __syncthreads();
}

constexpr int NWAVES = 8;
constexpr int MISC_OFF = 139264 + 64;
constexpr int LDS_BYTES = 147456;
struct Frame { LAS unsigned char* lds; int tid, lane, wave, vcu, G; float* out; unsigned char* ws; };
struct Args { const float* in[21]; float* out; unsigned char* ws; int st_lo, st_hi; };

template <class F> __device__ __forceinline__ void transpose_item(const F& f, int item, int nblk, bf16_t* dst, int ldd, LAS float* scr, int lane) {
    const int kb = item / nblk, nb = item % nblk, k0 = 64 * kb, n0 = 32 * nb;
#pragma unroll 8
    for (int i = 0; i < 32; ++i) { const int kk = 2 * i + (lane >> 5); scr[kk * 33 + (lane & 31)] = f(k0 + kk, n0 + (lane & 31)); }
    LDS_WAIT(); asm volatile("" ::: "memory");
    const int c = lane & 7;
#pragma unroll
    for (int j = 0; j < 4; ++j) { const int n = (lane >> 3) + 8 * j; const LAS float* s = scr + (8 * c) * 33 + n;
        u32x4 o; o.x = cvt_pk_bf16(s[0 * 33], s[1 * 33]); o.y = cvt_pk_bf16(s[2 * 33], s[3 * 33]); o.z = cvt_pk_bf16(s[4 * 33], s[5 * 33]); o.w = cvt_pk_bf16(s[6 * 33], s[7 * 33]);
        *(u32x4*)(dst + (size_t)(n0 + n) * ldd + k0 + 8 * c) = o; }
    LDS_WAIT(); asm volatile("" ::: "memory");
}
__device__ __forceinline__ int rope_perm(int p) { return (p >> 1) + 16 * (p & 1); }
struct SrcWz { const float* w; __device__ __forceinline__ float operator()(int k, int n) const {
    if (n < 640) return w[(size_t)k * INW + n]; if (n < 672) return w[(size_t)k * INW + 640 + rope_perm(n - 640)]; return 0.f; } };
struct SrcPlain { const float* w; int ld, coff; __device__ __forceinline__ float operator()(int k, int n) const { return w[(size_t)k * ld + coff + n]; } };
struct SrcGain { const float* w; const float* g; int ld; float sc; __device__ __forceinline__ float operator()(int k, int n) const { return w[(size_t)k * ld + n] * g[k] * sc; } };
struct SrcUq { const float* w; const float* g; __device__ __forceinline__ float operator()(int k, int n) const {
    const int h = n / DQK, e = n % DQK; const int src = h * DQK + (e < DN ? e : DN + rope_perm(e - DN)); return w[(size_t)k * 768 + src] * g[k] * QSCALE; } };
struct SrcGu { const float* w; const float* g; __device__ __forceinline__ float operator()(int k, int n) const {
    const int t = n >> 8, j = n & 255; const int src = (j < 128) ? (128 * t + j) : (DFF + 128 * t + (j - 128)); return w[(size_t)k * (2 * DFF) + src] * g[k]; } };

__constant__ double ROPE_INV[16] = {1.0, 0.5623413251903491, 0.31622776601683794, 0.1778279410038923, 0.1, 0.05623413251903491, 0.03162277660168379, 0.01778279410038923,
                                    0.01, 0.005623413251903491, 0.0031622776601683794, 0.0017782794100389228, 0.001, 0.0005623413251903491, 0.00031622776601683794, 0.00017782794100389227};

__device__ __forceinline__ void rms_row_to_bf16(const float* xrow, const f32x4 (&g)[4], bf16_t* orow, int lane) {
    const f32x4* xr = (const f32x4*)xrow + lane;
    f32x4 v[4]; float s = 0.f;
#pragma unroll
    for (int j = 0; j < 4; ++j) { v[j] = xr[64 * j]; s += (v[j][0] * v[j][0] + v[j][1] * v[j][1]) + (v[j][2] * v[j][2] + v[j][3] * v[j][3]); }
    const float r = __builtin_amdgcn_rsqf(wave_sum(s) * (1.f / DM) + EPS);
    u32x2* o8 = (u32x2*)orow + lane;
#pragma unroll
    for (int j = 0; j < 4; ++j) { const f32x4 y = v[j] * g[j] * r; u32x2 w; w.x = cvt_pk_bf16(y[0], y[1]); w.y = cvt_pk_bf16(y[2], y[3]); o8[64 * j] = w; }
}

__device__ __forceinline__ void p0_prologue(Frame& F, const Args& AR) {
    unsigned char* ws = F.ws; unsigned char* dob = (unsigned char*)F.out;
    bf16_t* WzT = (bf16_t*)(ws + WS_WZT); bf16_t* WfT = (bf16_t*)(ws + WS_WFT); bf16_t* WxkT = (bf16_t*)(ws + WS_WXKT); bf16_t* WxvT = (bf16_t*)(ws + WS_WXVT);
    bf16_t* WuqT = (bf16_t*)(ws + WS_WUQT); bf16_t* WukvT = (bf16_t*)(ws + WS_WUKVT); bf16_t* DFTM = (bf16_t*)(ws + WS_DFTM); bf16_t* WoutT = (bf16_t*)(ws + WS_WOUTT);
    bf16_t* WxqT = (bf16_t*)(ws + WS_WXQT); bf16_t* WxoT = (bf16_t*)(ws + WS_WXOT); bf16_t* WguT = (bf16_t*)(ws + WS_WGUT); bf16_t* WdT = (bf16_t*)(ws + WS_WDT);
    float* ropeC = (float*)(ws + WS_ROPEC); float* ropeS = (float*)(ws + WS_ROPES);
    bf16_t* XN = (bf16_t*)(ws + WS_R0); bf16_t* MN = (bf16_t*)(dob + DO_MN);
    const int gw = F.vcu * NWAVES + F.wave, NGW = F.G * NWAVES, gt = F.vcu * 512 + F.tid, NGT = F.G * 512;
    for (int it = F.vcu; it < 256; it += F.G) {
        const int g = it >> 6, k0 = (it & 63) * 16; LAS float* Wl = (LAS float*)F.lds;
#pragma unroll
        for (int e = 0; e < 4; ++e) { const int idx = F.tid + 512 * e; Wl[idx] = AR.in[5][(size_t)(k0 + (idx >> 7)) * INW + 672 + g * 128 + (idx & 127)]; }
        LDS_WAIT(); __syncthreads();
        const int nl = F.tid & 255, cs = nl >> 7, j = nl & 127, kh = F.tid >> 8; float a[8];
#pragma unroll
        for (int e = 0; e < 8; ++e) a[e] = 0.f;
        for (int c = 0; c < 128; ++c) { const float ph = (float)((j * c) & 127) * (1.0f / 128.0f); const float tv = cs ? __builtin_amdgcn_sinf(ph) : __builtin_amdgcn_cosf(ph);
#pragma unroll
            for (int e = 0; e < 8; ++e) a[e] += Wl[(kh * 8 + e) * 128 + c] * tv; }
        u32x4 o; o.x = cvt_pk_bf16(a[0], a[1]); o.y = cvt_pk_bf16(a[2], a[3]); o.z = cvt_pk_bf16(a[4], a[5]); o.w = cvt_pk_bf16(a[6], a[7]);
        *(u32x4*)(WfT + (size_t)(g * 256 + cs * 128 + j) * 1024 + k0 + kh * 8) = o;
        __syncthreads();
    }
    for (int it = F.vcu; it < 128; it += F.G) {
        const int g = it >> 5, n0 = (it & 31) * 32; LAS float* Wf = (LAS float*)F.lds; LAS float* Wo = (LAS float*)(F.lds + 65536);
#pragma unroll 8
        for (int e = 0; e < 32; ++e) { const int idx = F.tid + 512 * e; Wf[idx] = AR.in[10][(size_t)g * 16384 + idx]; }
#pragma unroll
        for (int e = 0; e < 8; ++e) { const int idx = F.tid + 512 * e; Wo[idx] = AR.in[11][(size_t)(512 + g * 128 + (idx >> 5)) * DM + n0 + (idx & 31)]; }
        LDS_WAIT(); __syncthreads();
        const int n = F.tid & 31, grp = F.tid >> 5; float a[8];
#pragma unroll
        for (int e = 0; e < 8; ++e) a[e] = 0.f;
        for (int c = 0; c < 128; ++c) { const float wv = Wo[c * 32 + n];
#pragma unroll
            for (int e = 0; e < 8; ++e) a[e] += Wf[(grp * 8 + e) * 128 + c] * wv; }
        u32x4 o; o.x = cvt_pk_bf16(a[0], a[1]); o.y = cvt_pk_bf16(a[2], a[3]); o.z = cvt_pk_bf16(a[4], a[5]); o.w = cvt_pk_bf16(a[6], a[7]);
        *(u32x4*)(WoutT + (size_t)(n0 + n) * 1024 + 512 + g * 128 + grp * 8) = o;
        __syncthreads();
    }
    {
        LAS float* scr = (LAS float*)(F.lds + F.wave * 16384);
        constexpr int I_WZ = 16 * 24, I_XK = 16 * 32, I_XV = 16 * 32, I_UQ = 6 * 24, I_UKV = 4 * 32, I_OUT = 8 * 32, I_XQ = 16 * 32, I_XO = 16 * 32, I_GU = 16 * 176, I_D = 44 * 32;
        constexpr int NITEMS = I_WZ + I_XK + I_XV + I_UQ + I_UKV + I_OUT + I_XQ + I_XO + I_GU + I_D;
        for (int it = gw; it < NITEMS; it += NGW) {
            int r = it;
            if (r < I_WZ) { transpose_item(SrcWz{AR.in[5]}, r, 24, WzT, 1024, scr, F.lane); continue; } r -= I_WZ;
            if (r < I_XK) { transpose_item(SrcPlain{AR.in[15], 2048, 0}, r, 32, WxkT, 1024, scr, F.lane); continue; } r -= I_XK;
            if (r < I_XV) { transpose_item(SrcPlain{AR.in[15], 2048, 1024}, r, 32, WxvT, 1024, scr, F.lane); continue; } r -= I_XV;
            if (r < I_UQ) { transpose_item(SrcUq{AR.in[7], AR.in[6]}, r, 24, WuqT, QL, scr, F.lane); continue; } r -= I_UQ;
            if (r < I_UKV) { transpose_item(SrcGain{AR.in[9], AR.in[8], 1024, 1.f}, r, 32, WukvT, KVL, scr, F.lane); continue; } r -= I_UKV;
            if (r < I_OUT) { transpose_item(SrcPlain{AR.in[11], 1024, 0}, r, 32, WoutT, 1024, scr, F.lane); continue; } r -= I_OUT;
            if (r < I_XQ) { transpose_item(SrcGain{AR.in[14], AR.in[12], 1024, XSCALE}, r, 32, WxqT, 1024, scr, F.lane); continue; } r -= I_XQ;
            if (r < I_XO) { transpose_item(SrcPlain{AR.in[16], 1024, 0}, r, 32, WxoT, 1024, scr, F.lane); continue; } r -= I_XO;
            if (r < I_GU) { transpose_item(SrcGu{AR.in[18], AR.in[17]}, r, 176, WguT, 1024, scr, F.lane); continue; } r -= I_GU;
            transpose_item(SrcPlain{AR.in[19], 1024, 0}, r, 32, WdT, DFF, scr, F.lane);
        }
    }
    for (int ch = gt; ch < 2048 * 512; ch += NGT) { const int k = ch >> 9, c0 = (ch & 511) * 8; float v[8];
#pragma unroll
        for (int e = 0; e < 8; ++e) { const int cc = c0 + e, s = cc & 2047; const float ph = (float)((k * s) & 2047) * (1.0f / 2048.0f);
            v[e] = (cc < 2048 ? __builtin_amdgcn_cosf(ph) : -__builtin_amdgcn_sinf(ph)) * (1.0f / 512.0f); }
        u32x4 o; o.x = cvt_pk_bf16(v[0], v[1]); o.y = cvt_pk_bf16(v[2], v[3]); o.z = cvt_pk_bf16(v[4], v[5]); o.w = cvt_pk_bf16(v[6], v[7]);
        *(u32x4*)(DFTM + (size_t)k * 4096 + c0) = o; }
    for (int idx = gt; idx < SEQ * 16; idx += NGT) { const int s = idx >> 4, i = idx & 15; const double rev = (double)s * ROPE_INV[i] * 0.15915494309189535; const float ph = (float)(rev - __builtin_floor(rev));
        ropeC[idx] = __builtin_amdgcn_cosf(ph); ropeS[idx] = __builtin_amdgcn_sinf(ph); }
    {
        f32x4 g[4];
#pragma unroll
        for (int j = 0; j < 4; ++j) g[j] = *((const f32x4*)AR.in[4] + F.lane + 64 * j);
        for (int m = gw; m < T; m += NGW) rms_row_to_bf16(m < TP ? AR.in[0] + (size_t)m * DM : AR.in[1] + (size_t)(m - TP) * DM, g, XN + (size_t)m * DM, F.lane);
#pragma unroll
        for (int j = 0; j < 4; ++j) g[j] = *((const f32x4*)AR.in[13] + F.lane + 64 * j);
        for (int m = gw; m < TMEM; m += NGW) rms_row_to_bf16(m < TMP ? AR.in[2] + (size_t)m * DM : AR.in[3] + (size_t)(m - TMP) * DM, g, MN + (size_t)m * DM, F.lane);
    }
}

__device__ __forceinline__ void final_norm(Frame& F, const Args& AR) {
    const float* PS = (const float*)(F.ws + WS_PS); const bf16_t* XB = (const bf16_t*)(F.ws + WS_R1);
    const int gw = F.vcu * NWAVES + F.wave, NGW = F.G * NWAVES;
    f32x4 g[4];
#pragma unroll
    for (int j = 0; j < 2; ++j) { g[2 * j] = *(const f32x4*)(AR.in[20] + j * 512 + 8 * F.lane); g[2 * j + 1] = *(const f32x4*)(AR.in[20] + j * 512 + 8 * F.lane + 4); }
    for (int m = gw; m < T; m += NGW) {
        const float pv = (F.lane < 16) ? PS[(size_t)m * 16 + F.lane] : 0.f;
        const float r = __builtin_amdgcn_rsqf(wave_sum(pv) * (1.f / DM) + EPS);
#pragma unroll
        for (int j = 0; j < 2; ++j) { const u32x4 w = *(const u32x4*)(XB + (size_t)m * DM + j * 512 + 8 * F.lane);
            const f32x4 y0 = (f32x4){__uint_as_float(w.x << 16), __uint_as_float(w.x & 0xffff0000u), __uint_as_float(w.y << 16), __uint_as_float(w.y & 0xffff0000u)};
            const f32x4 y1 = (f32x4){__uint_as_float(w.z << 16), __uint_as_float(w.z & 0xffff0000u), __uint_as_float(w.w << 16), __uint_as_float(w.w & 0xffff0000u)};
            float* o = F.out + (size_t)m * DM + j * 512 + 8 * F.lane;
            *(f32x4*)o = y0 * g[2 * j] * r; *(f32x4*)(o + 4) = y1 * g[2 * j + 1] * r; }
    }
}

constexpr int NSTEPS = 12;
__global__ void __launch_bounds__(NWAVES * 64, 2) fwd_kernel(Args args) {
    extern __shared__ __attribute__((aligned(16))) unsigned char lds_raw[];
    Frame F;
    F.lds = (LAS unsigned char*)lds_raw;
    F.tid = threadIdx.x; F.lane = F.tid & 63; F.wave = __builtin_amdgcn_readfirstlane(F.tid >> 6);
    F.G = GRID; { const int bx = blockIdx.x; F.vcu = (bx % 8) * (GRID / 8) + bx / 8; }
    F.out = args.out; F.ws = args.ws;
    volatile LAS unsigned* MISC = (volatile LAS unsigned*)(F.lds + MISC_OFF);
    if (F.tid < 32) MISC[F.tid] = 0u;
    __syncthreads();
    unsigned* ctl = (unsigned*)(F.ws + WS_CTL);
    XcdBarrier bar; bar.bar = ctl + CW_BAR; bar.x = 0; bar.st = nullptr;
    const int lo = args.st_lo, hi = args.st_hi;
    if (hi - lo > 1) bar = xcd_barrier_post(ctl + CW_BAR, MISC + 8);
#ifndef PH_MASK
#define PH_MASK 0xfff
#endif
#define IN(k) (((PH_MASK >> (k)) & 1) && lo <= (k) && (k) < hi)
#define SEAM(k) do { if (IN(k) && IN((k) + 1)) xcd_barrier(bar); } while (0)
#define MIB(x) ((int)((x) / MiB))
#ifndef REPEAT_PH
#define REPEAT_PH -1
#endif
#define TWICE(k, ...) do { __VA_ARGS__ if (REPEAT_PH == (k)) { xcd_barrier(bar); __VA_ARGS__ } } while (0)
    unsigned char* ws = F.ws; unsigned char* dob = (unsigned char*)F.out;
    Epi E; E.ws = ws; E.out = F.out; E.xp = nullptr; E.xs = nullptr;
    if (IN(0)) TWICE(0, { p0_prologue(F, args); }); SEAM(0);
    if (IN(1)) TWICE(1, { Sched<SK_P1, 0, 1024, 1024> S{(const char*)ws, (const char*)dob}; gemm_phase<SK_P1, 0, 1024, 1024, 1024, EK_P1, 0>(F.lds, S, E); }); SEAM(1);
    if (IN(2)) TWICE(2, {
        { Sched<SK_GEN, 3, ZW, QL> S{(const char*)(dob + DO_Z), (const char*)(ws + WS_WUQT)}; gemm_phase<SK_GEN, 3, ZW, QL, QL, EK_Q, 0>(F.lds, S, E); }
        { Sched<SK_GEN, 4, ZW, KVL> S{(const char*)(dob + DO_Z) + QL * 2, (const char*)(ws + WS_WUKVT)}; gemm_phase<SK_GEN, 4, ZW, KVL, KVL, EK_KV, 0>(F.lds, S, E); }
    }); SEAM(2);
    if (IN(3)) {
        TWICE(30, { Sched<SK_DFT, 0, 4096, 4096> S{(const char*)(ws + WS_DFTM), (const char*)(ws + WS_R1)}; gemm_phase<SK_DFT, 0, 4096, 4096, 4096, EK_DFT, MIB(WS_R0)>(F.lds, S, E); });
        const int c = (int)blockIdx.x, x = c & 7, j = c >> 3;
        const int nun = (j < 24) ? 5 : 9;
        const bf16_t* Qb = (const bf16_t*)(dob + DO_Q); const bf16_t* Kfb = (const bf16_t*)(ws + WS_KF); const bf16_t* Vb = (const bf16_t*)(ws + WS_V); bf16_t* Y = (bf16_t*)(ws + WS_R0);
        TWICE(31, {for (int r = 0; r < nun; ++r) {
            const int uidx = (j < 24) ? (72 + j + 24 * r) : ((j - 24) + 8 * r);
            const int bh = x * 24 + (uidx >> 3), qb = uidx & 7, b = bh >> 3, h = bh & 7;
            const size_t row0 = (size_t)b * SEQ;
            mla::attn_unit(Qb + (row0 + qb * 256) * 768 + h * DQK, Kfb + row0 * 768 + h * DQK, Vb + row0 * 512 + h * DVH, Y + (row0 + qb * 256) * 1024 + h * DVH, (char*)lds_raw);
        } });
    } SEAM(3);
    if (IN(4)) TWICE(4, { Epi E4 = E; E4.xp = args.in[0]; E4.xs = args.in[1];
        Sched<SK_GEN, 4, 1024, 1024> S{(const char*)(ws + WS_R0), (const char*)(ws + WS_WOUTT)}; gemm_phase<SK_GEN, 4, 1024, 1024, 1024, EK_RES_X, MIB(WS_R1)>(F.lds, S, E4); }); SEAM(4);
    if (IN(5)) TWICE(5, { Sched<SK_GEN, 4, 1024, 1024> S{(const char*)(ws + WS_R1), (const char*)(ws + WS_WXQT)}; gemm_phase<SK_GEN, 4, 1024, 1024, 1024, EK_ROWSCALE, MIB(WS_R0)>(F.lds, S, E); }); SEAM(5);
    if (IN(6)) TWICE(6, { Sched<SK_XS, 4, 1024, 1024> S{(const char*)(ws + WS_R0), (const char*)(ws + WS_KX)}; gemm_phase<SK_XS, 4, 1024, 1024, 256, EK_SOFTMAX, MIB(WS_R2)>(F.lds, S, E); }); SEAM(6);
    if (IN(7)) TWICE(7, { Sched<SK_XPV, 4, 1024, 256> S{(const char*)(ws + WS_R2), (const char*)(ws + WS_VXT)}; gemm_phase<SK_XPV, 4, 1024, 256, 256, EK_PLAIN, MIB(WS_R0)>(F.lds, S, E); }); SEAM(7);
    if (IN(8)) { Sched<SK_GEN, 4, 1024, 1024> S{(const char*)(ws + WS_R0), (const char*)(ws + WS_WXOT)}; gemm_phase<SK_GEN, 4, 1024, 1024, 1024, EK_RES, MIB(WS_R1)>(F.lds, S, E); } SEAM(8);
    if (IN(9)) TWICE(9, { Sched<SK_GEN, 22, 1024, 1024> S{(const char*)(ws + WS_R1), (const char*)(ws + WS_WGUT)}; gemm_phase<SK_GEN, 22, 1024, 1024, 1024, EK_SWIGLU, MIB(WS_H)>(F.lds, S, E); }); SEAM(9);
    if (IN(10)) { Sched<SK_GEN, 4, DFF, DFF> S{(const char*)(ws + WS_H), (const char*)(ws + WS_WDT)}; gemm_phase<SK_GEN, 4, DFF, DFF, DFF, EK_RES_NOB, 0>(F.lds, S, E); } SEAM(10);
    if (IN(11)) { final_norm(F, args); }
#undef IN
#undef SEAM
#undef MIB
}

extern "C" void kernel_launch(void* const* d_in, const int* in_sizes, int n_in, void* d_out, int out_size, void* d_ws, size_t ws_size, hipStream_t stream) {
    static int grid = 0;
    if (grid == 0) {
        if (n_in != 21 || in_sizes[0] != TP * DM || in_sizes[1] != (T - TP) * DM || out_size != T * DM || ws_size < WS_END) {
            fprintf(stderr, "kernel_launch: unexpected shapes (n_in %d, in0 %d, out %d, ws %zu); nothing launched\n", n_in, n_in > 0 ? in_sizes[0] : -1, out_size, ws_size); grid = -1; return; }
        int dev = 0, cus = 0, per_cu = 0;
        if (hipGetDevice(&dev) != hipSuccess || hipDeviceGetAttribute(&cus, hipDeviceAttributeMultiprocessorCount, dev) != hipSuccess) { grid = -1; return; }
        if (hipFuncSetAttribute((const void*)fwd_kernel, hipFuncAttributeMaxDynamicSharedMemorySize, LDS_BYTES) != hipSuccess) { fprintf(stderr, "kernel_launch: hipFuncSetAttribute failed\n"); grid = -1; return; }
        if (hipOccupancyMaxActiveBlocksPerMultiprocessor(&per_cu, (const void*)fwd_kernel, NWAVES * 64, LDS_BYTES) != hipSuccess || per_cu < 1) { fprintf(stderr, "kernel_launch: occupancy query says %d blocks/CU\n", per_cu); grid = -1; (void)hipGetLastError(); return; }
        (void)hipGetLastError();
        if (cus != 256) { fprintf(stderr, "kernel_launch: built for 256 CUs, device has %d\n", cus); grid = -1; return; }
        grid = cus;
    }
    if (grid < 0) return;
    (void)hipMemsetAsync((char*)d_ws + WS_CTL, 0, CTL_ZERO_BYTES, stream);
    Args a{};
    for (int i = 0; i < 21; ++i) a.in[i] = (const float*)d_in[i];
    a.out = (float*)d_out; a.ws = (unsigned char*)d_ws;
#if DBG_STEPS
    for (int st = 0; st < NSTEPS; ++st) { a.st_lo = st; a.st_hi = st + 1; hipLaunchKernelGGL(fwd_kernel, dim3(grid), dim3(NWAVES * 64), LDS_BYTES, stream, a); }
#else
    a.st_lo = 0; a.st_hi = NSTEPS;
    hipLaunchKernelGGL(fwd_kernel, dim3(grid), dim3(NWAVES * 64), LDS_BYTES, stream, a);
#endif
}
```

```cpp
#include <hip/hip_runtime.h>
#include <cstdio>
#include <cstdint>

#define LAS __attribute__((address_space(3)))
#define GAS __attribute__((address_space(1)))
typedef unsigned short bf16_t;
typedef short bf16x8 __attribute__((ext_vector_type(8)));
typedef short s16x4 __attribute__((ext_vector_type(4)));
typedef float f32x4 __attribute__((ext_vector_type(4)));
typedef float f32x2 __attribute__((ext_vector_type(2)));
typedef float f32x16 __attribute__((ext_vector_type(16)));
typedef unsigned u32x4 __attribute__((ext_vector_type(4)));
typedef unsigned u32x2 __attribute__((ext_vector_type(2)));

#ifndef DBG_STEPS
#define DBG_STEPS 0
#endif

constexpr int DM = 1024, SEQ = 2048, NB = 24, NBP = 16, T = NB * SEQ, TP = NBP * SEQ;
constexpr int MEML = 256, TMEM = NB * MEML, TMP = NBP * MEML;
constexpr int QL = 384, KVL = 256, DR = 32, FW = 512, INW = 1184;
constexpr int NH = 8, DN = 64, DVH = 64, DQK = 96;
constexpr int ZW = 768;
constexpr int DFF = 2816;
constexpr float EPS = 1e-6f;
constexpr float LOG2E = 1.4426950408889634f;
constexpr float QSCALE = 0.10206207261596577f * LOG2E;
constexpr float XSCALE = 0.0625f * LOG2E;

constexpr size_t MiB = 1u << 20;
constexpr size_t WS_CTL = 0, CTL_ZERO_BYTES = 65536;
constexpr size_t WS_WZT = 1 * MiB, WS_WFT = 3 * MiB, WS_WXKT = 5 * MiB, WS_WXVT = 7 * MiB, WS_WUQT = 9 * MiB, WS_WUKVT = 10 * MiB;
constexpr size_t WS_ROPEC = 11 * MiB, WS_ROPES = 11 * MiB + 128 * 1024;
constexpr size_t WS_DFTM = 12 * MiB, WS_WOUTT = 28 * MiB, WS_WXQT = 30 * MiB, WS_WXOT = 32 * MiB, WS_WGUT = 34 * MiB, WS_WDT = 45 * MiB;
constexpr size_t WS_R0 = 52 * MiB;
constexpr size_t WS_R1 = 148 * MiB;
constexpr size_t WS_R2 = 244 * MiB;
constexpr size_t WS_KF = WS_R2, WS_V = WS_R2 + 72 * MiB, WS_KX = WS_R2 + 120 * MiB, WS_VXT = WS_R2 + 132 * MiB, WS_H = WS_R2;
constexpr size_t WS_XF = 388 * MiB;
constexpr size_t WS_XL = 484 * MiB;
constexpr size_t WS_EQDQ = 485 * MiB;
constexpr size_t WS_PS = 508 * MiB;
constexpr size_t WS_END = 511 * MiB;
constexpr size_t DO_Z = 0, DO_MN = 72 * MiB, DO_PS1 = 84 * MiB, DO_Q = 96 * MiB;
constexpr int CW_BAR = 4096;

__device__ __forceinline__ unsigned cvt_pk_bf16(float lo, float hi) { unsigned r; asm volatile("v_cvt_pk_bf16_f32 %0, %1, %2" : "=v"(r) : "v"(lo), "v"(hi)); return r; }
__device__ __forceinline__ u32x4 pack8(f32x4 a, f32x4 b) { u32x4 w; w.x = cvt_pk_bf16(a[0], a[1]); w.y = cvt_pk_bf16(a[2], a[3]); w.z = cvt_pk_bf16(b[0], b[1]); w.w = cvt_pk_bf16(b[2], b[3]); return w; }
__device__ __forceinline__ float bf2f(bf16_t v) { return __uint_as_float(((unsigned)v) << 16); }
__device__ __forceinline__ float sumsq8(f32x4 a, f32x4 b) { return (a[0] * a[0] + a[1] * a[1]) + (a[2] * a[2] + a[3] * a[3]) + (b[0] * b[0] + b[1] * b[1]) + (b[2] * b[2] + b[3] * b[3]); }
__device__ __forceinline__ float fq_sum(float v) { v += __shfl_xor(v, 16); v += __shfl_xor(v, 32); return v; }
__device__ __forceinline__ float fq_max(float v) { v = fmaxf(v, __shfl_xor(v, 16)); v = fmaxf(v, __shfl_xor(v, 32)); return v; }
__device__ __forceinline__ float wave_sum(float v) {
#pragma unroll
    for (int o = 1; o < 64; o <<= 1) v += __shfl_xor(v, o);
    return v;
}
#define LDS_WAIT() asm volatile("s_waitcnt lgkmcnt(0)" ::: "memory")
#define VM_WAIT() asm volatile("s_waitcnt vmcnt(0)" ::: "memory")

namespace pg8 {
constexpr int BM = 256, BK = 64, HALF = 128, HTB = HALF * BK * 2, STAGE_BYTES = 8 * HTB;
__host__ __device__ __forceinline__ int lds_byte(int r, int c) { const int st = (r >> 4) * 2 + (c >> 5), rr = r & 15, cc = c & 31, ob = rr * 64 + cc * 2; return st * 1024 + (ob ^ (((ob >> 9) & 1) << 5)); }
__host__ __device__ __forceinline__ void stage_rc(int b, int& R, int& C) { const int st = b / 1024, sb = b % 1024, swz = sb ^ (((sb >> 9) & 1) << 5); R = (st >> 1) * 16 + swz / 64; C = (st & 1) * 32 + (swz % 64) / 2; }
__host__ __device__ __forceinline__ int perm32(int rho) { const int n = rho >> 4, i = rho & 15; return 8 * (i >> 2) + 4 * n + (i & 3); }
struct Unit { int pm, pn, ty; const char* a; const char* b; };
}
using pg8::Unit;

enum { SK_GEN = 0, SK_P1 = 1, SK_XS = 2, SK_XPV = 3, SK_DFT = 4 };
constexpr int GRID = 256;
__device__ __forceinline__ bool tile_of(int L, int nM, int nN, int& pm, int& pn) {
    const int nwg = nM * nN; if (L >= nwg || L < 0) return false;
    const int q = nwg / 8, r = nwg % 8, xcd = L % 8, off = L / 8;
    const int wgid = (xcd < r ? xcd * (q + 1) : r * (q + 1) + (xcd - r) * q) + off;
    const int nig = 8 * nN, gid = wgid / nig, fm = gid * 8, gsz = (nM - fm) < 8 ? (nM - fm) : 8;
    pm = fm + ((wgid % nig) % gsz); pn = (wgid % nig) / gsz; return true;
}
template <int KIND, int NN, int LDA, int LDB>
struct Sched {
    const char* A; const char* B;
    __device__ __forceinline__ bool next(int i, Unit& u) const {
        const int c = (int)blockIdx.x; const int L = i * GRID + c;
        u.ty = 0;
        if constexpr (KIND == SK_GEN) {
            if (!tile_of(L, 192, NN, u.pm, u.pn)) return false;
            u.a = A + (size_t)u.pm * ((size_t)512 * LDA); u.b = B + (size_t)u.pn * ((size_t)512 * LDB); return true;
        } else if constexpr (KIND == SK_P1) {
            constexpr size_t TS = (size_t)256 * 1024 * 2; const char* ws = A; const char* dob = B;
            if (L < 384) { tile_of(L, 2, 192, u.pm, u.pn); u.ty = 0; u.a = ws + WS_WFT + (size_t)(((u.pn >> 1) & 1) * 2 + u.pm) * TS; u.b = ws + WS_XF + u.pn * TS; return true; }
            if (L < 960) { tile_of(L - 384, 192, 3, u.pm, u.pn); u.ty = 1; u.a = ws + WS_R0 + u.pm * TS; u.b = ws + WS_WZT + u.pn * TS; return true; }
            if (L < 1056) { tile_of(L - 960, 24, 4, u.pm, u.pn); u.ty = 2; u.a = dob + DO_MN + u.pm * TS; u.b = ws + WS_WXKT + u.pn * TS; return true; }
            if (L < 1152) { tile_of(L - 1056, 4, 24, u.pm, u.pn); u.ty = 3; u.a = ws + WS_WXVT + u.pm * TS; u.b = dob + DO_MN + u.pn * TS; return true; }
            if (L < 1156) { const int e = L - 1152; u.pm = e & 1; u.pn = e >> 1; u.ty = 4; u.a = ws + WS_WFT + (size_t)(u.pn * 2 + u.pm) * TS; u.b = ws + WS_XL + u.pn * TS; return true; }
            return false;
        } else if constexpr (KIND == SK_XS) {
            if (!tile_of(L, 192, 4, u.pm, u.pn)) return false;
            u.a = A + (size_t)u.pm * ((size_t)512 * 1024) + (size_t)u.pn * 512; u.b = B + (size_t)(u.pm >> 3) * ((size_t)256 * 2048) + (size_t)u.pn * 512; return true;
        } else if constexpr (KIND == SK_XPV) {
            if (!tile_of(L, 192, 4, u.pm, u.pn)) return false;
            u.a = A + (size_t)u.pm * ((size_t)512 * 1024) + (size_t)u.pn * 512; u.b = B + (size_t)((u.pm >> 3) * 4 + u.pn) * 131072; return true;
        } else {
            const int x = c & 7, j = c >> 3; if (i >= 2 || (i == 1 && j >= 16)) return false;
            const int w = j + 32 * i, bb = 3 * x + (w >> 4), e16 = w & 15, eo = e16 >> 3; u.pm = e16 & 3; u.pn = (e16 >> 2) & 1; u.ty = bb * 2 + eo;
            u.a = A + (size_t)eo * (2 * MiB) + (size_t)u.pm * ((size_t)256 * 1024 * 2); u.b = B + ((size_t)((bb * 2 + eo) * 512 + u.pn * 256)) * 1024 * 2; return true;
        }
    }
};

enum { EK_P1 = 0, EK_Q, EK_KV, EK_DFT, EK_RES_X, EK_RES, EK_RES_NOB, EK_ROWSCALE, EK_SOFTMAX, EK_PLAIN, EK_SWIGLU };
struct Epi { unsigned char* ws; float* out; const float* xp; const float* xs; };
constexpr int LDS_SMX = 131072;

__device__ __forceinline__ float row_r16(const float* PS, int row, int fq) {
    const f32x4 p = *(const f32x4*)(PS + (size_t)row * 16 + fq * 4);
    const float tot = fq_sum((p[0] + p[1]) + (p[2] + p[3]));
    return __builtin_amdgcn_rsqf(tot * (1.0f / 1024.0f) + EPS);
}
__device__ __forceinline__ void rope8(f32x4& v0, f32x4& v1, const f32x4 cs4, const f32x4 sn4) {
    f32x4 o0, o1;
    o0[0] = v0[0] * cs4[0] - v0[1] * sn4[0]; o0[1] = v0[1] * cs4[0] + v0[0] * sn4[0];
    o0[2] = v0[2] * cs4[1] - v0[3] * sn4[1]; o0[3] = v0[3] * cs4[1] + v0[2] * sn4[1];
    o1[0] = v1[0] * cs4[2] - v1[1] * sn4[2]; o1[1] = v1[1] * cs4[2] + v1[0] * sn4[2];
    o1[2] = v1[2] * cs4[3] - v1[3] * sn4[3]; o1[3] = v1[3] * cs4[3] + v1[2] * sn4[3];
    v0 = o0; v1 = o1;
}
#define EPI_ARGS const Epi& E, f32x4 (&acc)[2][2][4][2], const Unit& u, int wr, int wc, int fr, int fq, LAS unsigned char* lds
#define EPI_ROWS for (int ai = 0; ai < 2; ++ai) _Pragma("unroll") for (int m = 0; m < 4; ++m)
#define EPI_FENCE() asm volatile("" ::: "memory")

__device__ __forceinline__ void epi_p1(EPI_ARGS) {
    const int rl0 = wr * 64 + fr, cl0 = wc * 32 + 8 * fq;
    if (u.ty == 0) {
        bf16_t* UT2 = (bf16_t*)(E.ws + WS_R1);
#pragma unroll
        EPI_ROWS { const int n = u.pm * 256 + ai * 128 + m * 16 + rl0;
#pragma unroll
            for (int bj = 0; bj < 2; ++bj) { const int t = u.pn * 256 + bj * 128 + cl0; const int b = t >> 11, blk = (t >> 9) & 3, sidx = t & 511;
                *(u32x4*)(UT2 + ((size_t)((b * 2 + (blk >> 1)) * 512 + n)) * 1024 + (blk & 1) * 512 + sidx) = pack8(acc[ai][bj][m][0], acc[ai][bj][m][1]); } }
    } else if (u.ty == 4) {
        float* QD = (float*)(E.ws + WS_EQDQ);
        if (wc == 0 && fq < 3) {
#pragma unroll
            EPI_ROWS { const int n = u.pm * 256 + ai * 128 + m * 16 + rl0;
#pragma unroll
                for (int e = 0; e < 4; ++e) { QD[(size_t)(u.pn * 24 + 8 * fq + e) * 512 + n] = acc[ai][0][m][0][e]; QD[(size_t)(u.pn * 24 + 8 * fq + 4 + e) * 512 + n] = acc[ai][0][m][1][e]; } }
        }
    } else if (u.ty == 1) {
        bf16_t* Z = (bf16_t*)((unsigned char*)E.out + DO_Z); float* PS1 = (float*)((unsigned char*)E.out + DO_PS1); bf16_t* Kf = (bf16_t*)(E.ws + WS_KF);
        const float* ropeC = (const float*)(E.ws + WS_ROPEC); const float* ropeS = (const float*)(E.ws + WS_ROPES);
#pragma unroll
        EPI_ROWS { const int row = u.pm * 256 + ai * 128 + m * 16 + rl0;
#pragma unroll
            for (int bj = 0; bj < 2; ++bj) { const int c = u.pn * 256 + bj * 128 + cl0; f32x4 v0 = acc[ai][bj][m][0], v1 = acc[ai][bj][m][1];
                *(u32x4*)(Z + (size_t)row * ZW + c) = pack8(v0, v1);
                const float ss = fq_sum(sumsq8(v0, v1)); const int half = u.pn * 2 + bj;
                if (half < 5 && fq == 0) PS1[(size_t)row * 24 + half * 4 + wc] = ss;
                if (half == 5 && wc == 0) {
                    const int pos = row & (SEQ - 1);
                    rope8(v0, v1, *(const f32x4*)(ropeC + pos * 16 + 4 * fq), *(const f32x4*)(ropeS + pos * 16 + 4 * fq));
                    const u32x4 w = pack8(v0, v1);
#pragma unroll
                    for (int h = 0; h < NH; ++h) *(u32x4*)(Kf + (size_t)row * 768 + h * DQK + DN + 8 * fq) = w;
                } } }
    } else if (u.ty == 2) {
        bf16_t* Kx = (bf16_t*)(E.ws + WS_KX);
#pragma unroll
        EPI_ROWS { const int row = u.pm * 256 + ai * 128 + m * 16 + rl0;
#pragma unroll
            for (int bj = 0; bj < 2; ++bj) *(u32x4*)(Kx + (size_t)row * 1024 + u.pn * 256 + bj * 128 + cl0) = pack8(acc[ai][bj][m][0], acc[ai][bj][m][1]); }
    } else {
        bf16_t* VxT = (bf16_t*)(E.ws + WS_VXT);
#pragma unroll
        EPI_ROWS { const int d = ai * 128 + m * 16 + rl0;
#pragma unroll
            for (int bj = 0; bj < 2; ++bj) *(u32x4*)(VxT + ((size_t)((u.pn * 4 + u.pm) * 256 + d)) * 256 + bj * 128 + cl0) = pack8(acc[ai][bj][m][0], acc[ai][bj][m][1]); }
    }
}
__device__ __forceinline__ void epi_q(EPI_ARGS) {
    const int rl0 = wr * 64 + fr, cl0 = wc * 32 + 8 * fq;
    const float* PS1 = (const float*)((unsigned char*)E.out + DO_PS1); bf16_t* Q = (bf16_t*)((unsigned char*)E.out + DO_Q);
    const float* ropeC = (const float*)(E.ws + WS_ROPEC); const float* ropeS = (const float*)(E.ws + WS_ROPES);
#pragma unroll
    EPI_ROWS { const int row = u.pm * 256 + ai * 128 + m * 16 + rl0; const int pos = row & (SEQ - 1);
        f32x4 p = {0.f, 0.f, 0.f, 0.f}; if (fq < 3) p = *(const f32x4*)(PS1 + (size_t)row * 24 + fq * 4);
        const float r = __builtin_amdgcn_rsqf(fq_sum((p[0] + p[1]) + (p[2] + p[3])) * (1.0f / QL) + EPS);
#pragma unroll
        for (int bj = 0; bj < 2; ++bj) { const int c = u.pn * 256 + bj * 128 + cl0; const int e = c % DQK;
            f32x4 v0 = acc[ai][bj][m][0] * r, v1 = acc[ai][bj][m][1] * r;
            if (e >= DN) { const int i0 = (e - DN) >> 1; rope8(v0, v1, *(const f32x4*)(ropeC + pos * 16 + i0), *(const f32x4*)(ropeS + pos * 16 + i0)); }
            *(u32x4*)(Q + (size_t)row * 768 + c) = pack8(v0, v1); }
        EPI_FENCE(); }
}
__device__ __forceinline__ void epi_kv(EPI_ARGS) {
    const int rl0 = wr * 64 + fr, cl0 = wc * 32 + 8 * fq;
    const float* PS1 = (const float*)((unsigned char*)E.out + DO_PS1); bf16_t* Kf = (bf16_t*)(E.ws + WS_KF); bf16_t* V = (bf16_t*)(E.ws + WS_V);
#pragma unroll
    EPI_ROWS { const int row = u.pm * 256 + ai * 128 + m * 16 + rl0;
        f32x4 p = {0.f, 0.f, 0.f, 0.f}; if (fq < 2) p = *(const f32x4*)(PS1 + (size_t)row * 24 + 12 + fq * 4);
        const float r = __builtin_amdgcn_rsqf(fq_sum((p[0] + p[1]) + (p[2] + p[3])) * (1.0f / KVL) + EPS);
#pragma unroll
        for (int bj = 0; bj < 2; ++bj) { const int c = u.pn * 256 + bj * 128 + cl0; const int h = c >> 7, e = c & 127;
            const u32x4 w = pack8(acc[ai][bj][m][0] * r, acc[ai][bj][m][1] * r);
            if (e < DN) *(u32x4*)(Kf + (size_t)row * 768 + h * DQK + e) = w; else *(u32x4*)(V + (size_t)row * 512 + h * DVH + (e - DN)) = w; }
        EPI_FENCE(); }
}
template <int OMIB> __device__ __forceinline__ void epi_plain(EPI_ARGS, int rowbase, int colbase) {
    const int rl0 = wr * 64 + fr, cl0 = wc * 32 + 8 * fq;
    bf16_t* O = (bf16_t*)(E.ws + (size_t)OMIB * MiB);
#pragma unroll
    EPI_ROWS { const int row = rowbase + ai * 128 + m * 16 + rl0;
#pragma unroll
        for (int bj = 0; bj < 2; ++bj) *(u32x4*)(O + (size_t)row * 1024 + colbase + bj * 128 + cl0) = pack8(acc[ai][bj][m][0], acc[ai][bj][m][1]); }
}
__device__ __forceinline__ void epi_dft(EPI_ARGS) {
    const int rl0 = wr * 64 + fr, cl0 = wc * 32 + 8 * fq; const int bb = u.ty >> 1, eo = u.ty & 1;
    bf16_t* Y = (bf16_t*)(E.ws + WS_R0); const float* QD = (const float*)(E.ws + WS_EQDQ) + (size_t)(eo * 24 + bb) * 512 + u.pn * 256 + cl0;
    const float sg = ((fr & 1) ? -1.0f : 1.0f) * (eo ? -1.0f : 1.0f) * (1.0f / 512.0f);
    f32x4 lv[2][2];
#pragma unroll
    for (int bj = 0; bj < 2; ++bj) { lv[bj][0] = *(const f32x4*)(QD + bj * 128) * sg; lv[bj][1] = *(const f32x4*)(QD + bj * 128 + 4) * sg; }
#pragma unroll
    EPI_ROWS { const int r = u.pm * 256 + ai * 128 + m * 16 + rl0; const size_t row = (size_t)bb * SEQ + 2 * r + eo;
#pragma unroll
        for (int bj = 0; bj < 2; ++bj) *(u32x4*)(Y + row * 1024 + 512 + u.pn * 256 + bj * 128 + cl0) = pack8(acc[ai][bj][m][0] + lv[bj][0], acc[ai][bj][m][1] + lv[bj][1]); }
}
template <int EKIND, int OMIB> __device__ __forceinline__ void epi_res(EPI_ARGS) {
    const int rl0 = wr * 64 + fr, cl0 = wc * 32 + 8 * fq;
    bf16_t* XB = (bf16_t*)(E.ws + WS_R1); float* PS = (float*)(E.ws + WS_PS);
#pragma unroll
    EPI_ROWS { const int row = u.pm * 256 + ai * 128 + m * 16 + rl0;
        float ss = 0.f;
#pragma unroll
        for (int bj = 0; bj < 2; ++bj) { const int c = u.pn * 256 + bj * 128 + cl0;
            f32x4 y0, y1;
            if constexpr (EKIND == EK_RES_X) { const float* rs = (row < TP ? E.xp + (size_t)row * DM : E.xs + (size_t)(row - TP) * DM); y0 = *(const f32x4*)(rs + c); y1 = *(const f32x4*)(rs + c + 4); }
            else { const u32x4 w = *(const u32x4*)(XB + (size_t)row * DM + c);
                y0 = (f32x4){__uint_as_float(w.x << 16), __uint_as_float(w.x & 0xffff0000u), __uint_as_float(w.y << 16), __uint_as_float(w.y & 0xffff0000u)};
                y1 = (f32x4){__uint_as_float(w.z << 16), __uint_as_float(w.z & 0xffff0000u), __uint_as_float(w.w << 16), __uint_as_float(w.w & 0xffff0000u)}; }
            y0 += acc[ai][bj][m][0]; y1 += acc[ai][bj][m][1];
            *(u32x4*)(XB + (size_t)row * DM + c) = pack8(y0, y1);
            ss += sumsq8(y0, y1); }
        ss = fq_sum(ss);
        if (fq == 0) PS[(size_t)row * 16 + u.pn * 4 + wc] = ss;
        EPI_FENCE(); }
}
template <int OMIB> __device__ __forceinline__ void epi_rowscale(EPI_ARGS) {
    const int rl0 = wr * 64 + fr, cl0 = wc * 32 + 8 * fq;
    bf16_t* O = (bf16_t*)(E.ws + (size_t)OMIB * MiB); const float* PS = (const float*)(E.ws + WS_PS);
#pragma unroll
    EPI_ROWS { const int row = u.pm * 256 + ai * 128 + m * 16 + rl0; const float r = row_r16(PS, row, fq);
#pragma unroll
        for (int bj = 0; bj < 2; ++bj) *(u32x4*)(O + (size_t)row * 1024 + u.pn * 256 + bj * 128 + cl0) = pack8(acc[ai][bj][m][0] * r, acc[ai][bj][m][1] * r);
        EPI_FENCE(); }
}
template <int OMIB> __device__ __forceinline__ void epi_swiglu(EPI_ARGS) {
    const int rl0 = wr * 64 + fr, cl0 = wc * 32 + 8 * fq;
    bf16_t* O = (bf16_t*)(E.ws + (size_t)OMIB * MiB); const float* PS = (const float*)(E.ws + WS_PS);
#pragma unroll
    EPI_ROWS { const int row = u.pm * 256 + ai * 128 + m * 16 + rl0; const float r = row_r16(PS, row, fq);
        f32x4 h[2];
#pragma unroll
        for (int n = 0; n < 2; ++n)
#pragma unroll
            for (int e = 0; e < 4; ++e) { const float g = acc[ai][0][m][n][e] * r, up = acc[ai][1][m][n][e] * r;
                h[n][e] = g * __builtin_amdgcn_rcpf(1.0f + __builtin_amdgcn_exp2f(-g * LOG2E)) * up; }
        *(u32x4*)(O + (size_t)row * DFF + u.pn * 128 + cl0) = pack8(h[0], h[1]);
        EPI_FENCE(); }
}
template <int OMIB> __device__ __forceinline__ void epi_softmax(EPI_ARGS) {
    const int rl0 = wr * 64 + fr, cl0 = wc * 32 + 8 * fq;
    bf16_t* O = (bf16_t*)(E.ws + (size_t)OMIB * MiB);
    LAS f32x2* TB = (LAS f32x2*)(lds + LDS_SMX);
    float mloc[2][4];
#pragma unroll
    EPI_ROWS {
        float mx = -3.0e38f;
#pragma unroll
        for (int bj = 0; bj < 2; ++bj)
#pragma unroll
            for (int n = 0; n < 2; ++n)
#pragma unroll
                for (int e = 0; e < 4; ++e) mx = fmaxf(mx, acc[ai][bj][m][n][e]);
        mx = fq_max(mx); float s = 0.f;
#pragma unroll
        for (int bj = 0; bj < 2; ++bj)
#pragma unroll
            for (int n = 0; n < 2; ++n)
#pragma unroll
                for (int e = 0; e < 4; ++e) { const float p = __builtin_amdgcn_exp2f(acc[ai][bj][m][n][e] - mx); acc[ai][bj][m][n][e] = p; s += p; }
        s = fq_sum(s); mloc[ai][m] = mx;
        if (fq == 0) TB[(ai * 128 + m * 16 + rl0) * 4 + wc] = (f32x2){mx, s};
    }
    LDS_WAIT(); __builtin_amdgcn_s_barrier(); asm volatile("" ::: "memory");
#pragma unroll
    EPI_ROWS { const int rl = ai * 128 + m * 16 + rl0; const int row = u.pm * 256 + rl;
        const f32x2 t0 = TB[rl * 4 + 0], t1 = TB[rl * 4 + 1], t2 = TB[rl * 4 + 2], t3 = TB[rl * 4 + 3];
        const float M = fmaxf(fmaxf(t0.x, t1.x), fmaxf(t2.x, t3.x));
        const float L = t0.y * __builtin_amdgcn_exp2f(t0.x - M) + t1.y * __builtin_amdgcn_exp2f(t1.x - M) + t2.y * __builtin_amdgcn_exp2f(t2.x - M) + t3.y * __builtin_amdgcn_exp2f(t3.x - M);
        const float f = __builtin_amdgcn_exp2f(mloc[ai][m] - M) * __builtin_amdgcn_rcpf(L);
#pragma unroll
        for (int bj = 0; bj < 2; ++bj) *(u32x4*)(O + (size_t)row * 1024 + u.pn * 256 + bj * 128 + cl0) = pack8(acc[ai][bj][m][0] * f, acc[ai][bj][m][1] * f); }
    LDS_WAIT(); __builtin_amdgcn_s_barrier(); asm volatile("" ::: "memory");
}
template <int EKIND, int OMIB> __device__ __forceinline__ void epilogue(EPI_ARGS) {
    if constexpr (EKIND == EK_P1) epi_p1(E, acc, u, wr, wc, fr, fq, lds);
    else if constexpr (EKIND == EK_Q) epi_q(E, acc, u, wr, wc, fr, fq, lds);
    else if constexpr (EKIND == EK_KV) epi_kv(E, acc, u, wr, wc, fr, fq, lds);
    else if constexpr (EKIND == EK_DFT) epi_dft(E, acc, u, wr, wc, fr, fq, lds);
    else if constexpr (EKIND == EK_RES || EKIND == EK_RES_X || EKIND == EK_RES_NOB) epi_res<EKIND, OMIB>(E, acc, u, wr, wc, fr, fq, lds);
    else if constexpr (EKIND == EK_ROWSCALE) epi_rowscale<OMIB>(E, acc, u, wr, wc, fr, fq, lds);
    else if constexpr (EKIND == EK_PLAIN) epi_plain<OMIB>(E, acc, u, wr, wc, fr, fq, lds, u.pm * 256, u.pn * 256);
    else if constexpr (EKIND == EK_SWIGLU) epi_swiglu<OMIB>(E, acc, u, wr, wc, fr, fq, lds);
    else epi_softmax<OMIB>(E, acc, u, wr, wc, fr, fq, lds);
}

template <int SKIND, int NN, int LDA, int LDB, int K, int EKIND, int OMIB>
__device__ __forceinline__ void gemm_phase(LAS unsigned char* lds, const Sched<SKIND, NN, LDA, LDB>& S, const Epi& E) {
    constexpr int lda = LDA, ldb = LDB;
    using namespace pg8;
    const int tid = threadIdx.x, wid = __builtin_amdgcn_readfirstlane(tid >> 6), lane = tid & 63, wr = wid >> 2, wc = wid & 3, fr = lane & 15, fq = lane >> 4;
    const int nt = K / BK;
    unsigned voffA[2], voffB[2];
#pragma unroll
    for (int i = 0; i < 2; ++i) { int R, C; stage_rc(tid * 16 + i * 8192, R, C); const int Rb = (R & ~31) + perm32(R & 31);
        voffA[i] = (unsigned)(R * lda + C) * 2u; voffB[i] = (unsigned)(Rb * ldb + C) * 2u; }
    const size_t kstep = (size_t)(BK * 2);
    const size_t hstepA = (size_t)HALF * lda * 2, hstepB = (size_t)HALF * ldb * 2;
    const unsigned ldsw = (unsigned)wid * 1024u;
    const int aoff = lds_byte(wr * 64 + fr, fq * 8), boff = lds_byte(wc * 32 + fr, fq * 8);
#define PG8_SA(b, h) (((b) * 2 + (h)) * HTB)
#define PG8_SB(b, h) ((4 + (b) * 2 + (h)) * HTB)
#define PG8_STAGE(bufoff, gbase, voff) do { _Pragma("unroll") for (int _i = 0; _i < 2; ++_i) \
        __builtin_amdgcn_global_load_lds((const unsigned*)((const char*)(gbase) + (voff)[_i]), (LAS unsigned*)(lds + (bufoff) + ldsw + _i * 8192), 16, 0, 0); } while (0)
#define PG8_LDA(dst, b, h) do { _Pragma("unroll") for (int m = 0; m < 4; ++m) _Pragma("unroll") for (int k = 0; k < 2; ++k) dst[m][k] = *(const LAS bf16x8*)(lds + PG8_SA(b, h) + aoff + m * 2048 + k * 1024); } while (0)
#define PG8_LDB(dst, b, h) do { _Pragma("unroll") for (int n = 0; n < 2; ++n) _Pragma("unroll") for (int k = 0; k < 2; ++k) dst[n][k] = *(const LAS bf16x8*)(lds + PG8_SB(b, h) + boff + n * 2048 + k * 1024); } while (0)
#define PG8_MMA(ai, bj, At, Bt) do { __builtin_amdgcn_s_setprio(1); _Pragma("unroll") for (int m = 0; m < 4; ++m) _Pragma("unroll") for (int n = 0; n < 2; ++n) _Pragma("unroll") for (int k = 0; k < 2; ++k) \
        acc[ai][bj][m][n] = __builtin_amdgcn_mfma_f32_16x16x32_bf16(Bt[n][k], At[m][k], acc[ai][bj][m][n], 0, 0, 0); __builtin_amdgcn_s_setprio(0); } while (0)
#define PG8_WAIT_V(n) asm volatile("s_waitcnt vmcnt(" #n ")" ::: "memory")
#define PG8_WAIT_L(n) asm volatile("s_waitcnt lgkmcnt(" #n ")" ::: "memory")
#define PG8_BAR __builtin_amdgcn_s_barrier()
#define PG8_SCHED __builtin_amdgcn_sched_barrier(0)
    Unit cur, nxt; int ui = 0;
    if (!S.next(0, cur)) return;
    f32x4 acc[2][2][4][2];
#pragma unroll
    for (int a = 0; a < 2; ++a)
#pragma unroll
        for (int b = 0; b < 2; ++b)
#pragma unroll
            for (int m = 0; m < 4; ++m)
#pragma unroll
                for (int n = 0; n < 2; ++n) acc[a][b][m][n] = (f32x4){0.f, 0.f, 0.f, 0.f};
    bf16x8 At[4][2], B0[2][2], B1[2][2];
    const char* cA = cur.a; const char* cB = cur.b;
    PG8_STAGE(PG8_SB(0, 0), cB, voffB); PG8_STAGE(PG8_SB(0, 1), cB + hstepB, voffB); PG8_STAGE(PG8_SA(0, 0), cA, voffA); PG8_STAGE(PG8_SA(0, 1), cA + hstepA, voffA);
    if (wr == 1) PG8_BAR;
    PG8_WAIT_V(2); PG8_BAR;
    PG8_STAGE(PG8_SB(1, 0), cB + kstep, voffB); PG8_STAGE(PG8_SA(1, 0), cA + kstep, voffA); PG8_STAGE(PG8_SB(1, 1), cB + hstepB + kstep, voffB);
    PG8_WAIT_V(6); PG8_BAR;
    for (;;) {
        const bool has_next = S.next(ui + 1, nxt);
        const char* nA = has_next ? nxt.a : cA; const char* nB = has_next ? nxt.b : cB;
#pragma unroll 1
        for (int t = 0; t < nt; t += 2) {
            const bool last = (t == nt - 2);
            const char* a1 = cA + (size_t)(t + 1) * kstep;
            const char* a2 = last ? nA : cA + (size_t)(t + 2) * kstep; const char* b2 = last ? nB : cB + (size_t)(t + 2) * kstep;
            const char* a3 = a2 + kstep; const char* b3 = b2 + kstep;
            PG8_LDB(B0, 0, 0); PG8_LDB(B1, 0, 1); PG8_SCHED; PG8_LDA(At, 0, 0); PG8_STAGE(PG8_SA(1, 1), a1 + hstepA, voffA);
            PG8_WAIT_V(8); PG8_WAIT_L(0); PG8_BAR; PG8_MMA(0, 0, At, B0); PG8_MMA(0, 1, At, B1); PG8_BAR; PG8_SCHED;
            PG8_LDA(At, 0, 1); PG8_STAGE(PG8_SB(0, 0), b2, voffB); PG8_STAGE(PG8_SB(0, 1), b2 + hstepB, voffB); PG8_STAGE(PG8_SA(0, 0), a2, voffA);
            PG8_WAIT_V(8); PG8_WAIT_L(0); PG8_BAR; PG8_MMA(1, 0, At, B0); PG8_MMA(1, 1, At, B1); PG8_BAR; PG8_SCHED;
            PG8_LDB(B0, 1, 0); PG8_LDB(B1, 1, 1); PG8_SCHED; PG8_LDA(At, 1, 0); PG8_STAGE(PG8_SA(0, 1), a2 + hstepA, voffA);
            PG8_WAIT_V(8); PG8_WAIT_L(0); PG8_BAR; PG8_MMA(0, 0, At, B0); PG8_MMA(0, 1, At, B1); PG8_BAR; PG8_SCHED;
            PG8_LDA(At, 1, 1); PG8_STAGE(PG8_SB(1, 0), b3, voffB); PG8_STAGE(PG8_SB(1, 1), b3 + hstepB, voffB); PG8_STAGE(PG8_SA(1, 0), a3, voffA);
            PG8_WAIT_V(8); PG8_WAIT_L(0); PG8_BAR; PG8_MMA(1, 0, At, B0); PG8_MMA(1, 1, At, B1); PG8_BAR; PG8_SCHED;
        }
        if (wr == 0) PG8_BAR;
        epilogue<EKIND, OMIB>(E, acc, cur, wr, wc, fr, fq, lds);
        if (!has_next) break;
#pragma unroll
        for (int a = 0; a < 2; ++a)
#pragma unroll
            for (int b = 0; b < 2; ++b)
#pragma unroll
                for (int m = 0; m < 4; ++m)
#pragma unroll
                    for (int n = 0; n < 2; ++n) acc[a][b][m][n] = (f32x4){0.f, 0.f, 0.f, 0.f};
        cur = nxt; cA = nA; cB = nB; ++ui;
        if (wr == 1) PG8_BAR;
    }
    PG8_WAIT_V(0);
    PG8_BAR;
#undef PG8_SA
#undef PG8_SB
#undef PG8_STAGE
#undef PG8_LDA
#undef PG8_LDB
#undef PG8_MMA
#undef PG8_WAIT_V
#undef PG8_WAIT_L
#undef PG8_BAR
#undef PG8_SCHED
}

namespace mla {
constexpr int NW = 8, QBLK = 32, KVBLK = 64;
constexpr int SHM_V = KVBLK * DVH * 2, SHM_K = KVBLK * 256;
constexpr int OFF_V = 0, OFF_K = 2 * SHM_V, OFF_WS = OFF_K + 2 * SHM_K, OFF_OST = OFF_WS + NW * 64 * 4, BYTES = OFF_OST + NW * 4096;
constexpr float THR = 11.5f;
#define KSWZ(row, colB) ((row) * 256 + ((colB) ^ (((row) & 7) << 4)))
#define SBAR() __builtin_amdgcn_sched_barrier(0)
__device__ __forceinline__ int crow(int r, int hi) { return (r & 3) + 8 * (r >> 2) + 4 * hi; }
__device__ __forceinline__ void partialSM(f32x16& p0, f32x16& p1, float& m_reg, float& mn, float& alpha) {
    float pmax = p0[0];
#pragma unroll
    for (int r = 1; r < 16; ++r) pmax = fmaxf(pmax, p0[r]);
#pragma unroll
    for (int r = 0; r < 16; ++r) pmax = fmaxf(pmax, p1[r]);
    { auto rr = __builtin_amdgcn_permlane32_swap(__float_as_uint(pmax), __float_as_uint(pmax), false, false); pmax = fmaxf(__uint_as_float(rr[0]), __uint_as_float(rr[1])); }
    if (__builtin_expect(__all(pmax - m_reg <= THR), 1)) { mn = m_reg; alpha = 1.f; }
    else { mn = fmaxf(m_reg, pmax); alpha = __builtin_amdgcn_exp2f(m_reg - mn); m_reg = mn; }
#pragma unroll
    for (int r = 0; r < 16; ++r) p0[r] = p0[r] - mn;
#pragma unroll
    for (int r = 0; r < 16; ++r) p1[r] = p1[r] - mn;
#pragma unroll
    for (int r = 0; r < 16; ++r) p0[r] = __builtin_amdgcn_exp2f(p0[r]);
}
__device__ __forceinline__ void finishSM(f32x16& p0, f32x16& p1, float alpha, float& l_reg, bf16x8& pa0, bf16x8& pa1, bf16x8& pa2, bf16x8& pa3) {
#pragma unroll
    for (int r = 0; r < 16; ++r) p1[r] = __builtin_amdgcn_exp2f(p1[r]);
    float ps = 0;
#pragma unroll
    for (int r = 0; r < 16; ++r) ps += p0[r];
#pragma unroll
    for (int r = 0; r < 16; ++r) ps += p1[r];
    { auto rr = __builtin_amdgcn_permlane32_swap(__float_as_uint(ps), __float_as_uint(ps), false, false); ps = __uint_as_float(rr[0]) + __uint_as_float(rr[1]); }
    l_reg = l_reg * alpha + ps;
#define PK4(P, BASE, OUT) do { unsigned a0 = cvt_pk_bf16(P[BASE + 0], P[BASE + 1]), a1 = cvt_pk_bf16(P[BASE + 2], P[BASE + 3]);   \
    unsigned b0 = cvt_pk_bf16(P[BASE + 4], P[BASE + 5]), b1 = cvt_pk_bf16(P[BASE + 6], P[BASE + 7]);                              \
    auto r0 = __builtin_amdgcn_permlane32_swap(a0, b0, false, false); auto r1 = __builtin_amdgcn_permlane32_swap(a1, b1, false, false); \
    u32x4 w = {r0[0], r1[0], r0[1], r1[1]}; OUT = *reinterpret_cast<bf16x8*>(&w); } while (0)
    PK4(p0, 0, pa0); PK4(p0, 8, pa1); PK4(p1, 0, pa2); PK4(p1, 8, pa3);
#undef PK4
}
__device__ __forceinline__ void qkt(f32x16& p0, f32x16& p1, const char* Ks, const bf16x8* qr, int r32, int hi) {
    p0 = f32x16{}; p1 = f32x16{};
#pragma unroll
    for (int d0 = 0; d0 < DQK / 16; ++d0) { const int cb = (d0 * 16 + hi * 8) * 2;
        const bf16x8 b0 = *reinterpret_cast<const bf16x8*>(Ks + KSWZ(r32, cb));
        const bf16x8 b1 = *reinterpret_cast<const bf16x8*>(Ks + KSWZ(32 + r32, cb));
        p0 = __builtin_amdgcn_mfma_f32_32x32x16_bf16(b0, qr[d0], p0, 0, 0, 0);
        p1 = __builtin_amdgcn_mfma_f32_32x32x16_bf16(b1, qr[d0], p1, 0, 0, 0); }
}
__device__ __forceinline__ int v_st(int k, int c) { const int kk = (k & ~0xC) | ((k & 4) << 1) | ((k & 8) >> 1); return ((kk >> 3) * 2 + (c >> 5)) * 512 + ((kk & 7) * 32 + (c & 31)) * 2; }
__device__ __forceinline__ int v_rd_base(int lane) { return ((lane & 3) << 3) | (((lane >> 2) & 3) << 6) | (((lane >> 4) & 1) << 5) | (((lane >> 5) & 1) << 8); }
constexpr int v_rd_off(int d0, int ks, int half) { return d0 * 512 + ks * 2048 + half * 1024; }
template <int OFF> __device__ __forceinline__ s16x4 tr_read(int vb) { s16x4 r; asm volatile("ds_read_b64_tr_b16 %0, %1 offset:%2" : "=&v"(r) : "v"(vb), "i"(OFF) : "memory"); return r; }
template <int D0> __device__ __forceinline__ void pv_one(f32x16& od, int vb, bf16x8 pa0, bf16x8 pa1, bf16x8 pa2, bf16x8 pa3) {
    const s16x4 l0 = tr_read<v_rd_off(D0, 0, 0)>(vb), h0 = tr_read<v_rd_off(D0, 0, 1)>(vb), l1 = tr_read<v_rd_off(D0, 1, 0)>(vb), h1 = tr_read<v_rd_off(D0, 1, 1)>(vb);
    const s16x4 l2 = tr_read<v_rd_off(D0, 2, 0)>(vb), h2 = tr_read<v_rd_off(D0, 2, 1)>(vb), l3 = tr_read<v_rd_off(D0, 3, 0)>(vb), h3 = tr_read<v_rd_off(D0, 3, 1)>(vb);
    asm volatile("s_waitcnt lgkmcnt(0)" ::: "memory"); SBAR();
#define PK(L, H) (bf16x8){L[0], L[1], L[2], L[3], H[0], H[1], H[2], H[3]}
    od = __builtin_amdgcn_mfma_f32_32x32x16_bf16(pa0, PK(l0, h0), od, 0, 0, 0);
    od = __builtin_amdgcn_mfma_f32_32x32x16_bf16(pa1, PK(l1, h1), od, 0, 0, 0);
    od = __builtin_amdgcn_mfma_f32_32x32x16_bf16(pa2, PK(l2, h2), od, 0, 0, 0);
    od = __builtin_amdgcn_mfma_f32_32x32x16_bf16(pa3, PK(l3, h3), od, 0, 0, 0);
#undef PK
}
__device__ __forceinline__ void pv_d0(f32x16* o, int vb, bf16x8 pa0, bf16x8 pa1, bf16x8 pa2, bf16x8 pa3) {
    pv_one<0>(o[0], vb, pa0, pa1, pa2, pa3); pv_one<1>(o[1], vb, pa0, pa1, pa2, pa3);
}
__device__ __forceinline__ void attn_unit(const bf16_t* __restrict__ Qb, const bf16_t* __restrict__ Kh, const bf16_t* __restrict__ Vh, bf16_t* __restrict__ Ob, char* lds) {
    constexpr int LDQ = 768, LDK = 768, LDV = 512, LDO = 1024;
    const int tid = threadIdx.x, wid = tid >> 6, lane = tid & 63, r32 = lane & 31, hi = lane >> 5;
    char* V_lds = lds + OFF_V; char* K_lds = lds + OFF_K;
    float* ws = (float*)(lds + OFF_WS) + wid * 64; float* li_l = ws; float* al_l = ws + 32;
    float m_reg = -1e30f, l_reg = 0; f32x16 o[2] = {}; bf16x8 qr[DQK / 16];
    const bf16_t* Qw = Qb + (size_t)(wid * QBLK + r32) * LDQ + hi * 8;
#pragma unroll
    for (int d0 = 0; d0 < DQK / 16; ++d0) qr[d0] = *reinterpret_cast<const bf16x8*>(Qw + d0 * 16);
    const int vr = tid >> 3, vc = (tid & 7) * 8, vst = v_st(vr, vc);
    const int kr0 = tid >> 3, kc0 = (tid & 7) * 8, kst0 = KSWZ(kr0, kc0 * 2);
    const bool k1 = tid < 256; const int kr1 = (tid >> 2) & 63, kc1 = 64 + (tid & 3) * 8, kst1 = KSWZ(kr1, kc1 * 2);
    const int vb0 = (int)(uintptr_t)V_lds + v_rd_base(lane);
    struct { bf16x8 vs, ks0, ks1; } sr_[2];
#define SLOAD(i, k0) do { sr_[i].vs = *reinterpret_cast<const bf16x8*>(&Vh[(size_t)((k0) + vr) * LDV + vc]); \
    sr_[i].ks0 = *reinterpret_cast<const bf16x8*>(&Kh[(size_t)((k0) + kr0) * LDK + kc0]); \
    if (k1) sr_[i].ks1 = *reinterpret_cast<const bf16x8*>(&Kh[(size_t)((k0) + kr1) * LDK + kc1]); } while (0)
#define SWRITE(b, i) do { *(bf16x8*)(V_lds + (b) * SHM_V + vst) = sr_[i].vs; *(bf16x8*)(K_lds + (b) * SHM_K + kst0) = sr_[i].ks0; \
    if (k1) *(bf16x8*)(K_lds + (b) * SHM_K + kst1) = sr_[i].ks1; } while (0)
#define RESC(a) do { if (__any((a) < 1.f)) { if (hi == 0) al_l[r32] = (a); asm volatile("s_waitcnt lgkmcnt(0)" ::: "memory"); \
    _Pragma("unroll") for (int d = 0; d < 2; ++d) _Pragma("unroll") for (int r = 0; r < 16; ++r) o[d][r] *= al_l[crow(r, hi)]; } } while (0)
    f32x16 pA0, pA1, pB0, pB1; float mnA, mnB, alA, alB; bf16x8 pa0, pa1, pa2, pa3; constexpr int NT = SEQ / KVBLK;
    constexpr int SE = 0, SO = 1;
    SLOAD(SE, 0); asm volatile("s_waitcnt vmcnt(0)" ::: "memory"); SWRITE(0, SE); __syncthreads();
    qkt(pA0, pA1, K_lds, qr, r32, hi); partialSM(pA0, pA1, m_reg, mnA, alA);
    SLOAD(SO, KVBLK); SLOAD(SE, 2 * KVBLK);
    SWRITE(1, SO); __syncthreads();
    for (int j = 1; j + 1 < NT; j += 2) {
        SBAR(); qkt(pB0, pB1, K_lds + SHM_K, qr, r32, hi);
        finishSM(pA0, pA1, alA, l_reg, pa0, pa1, pa2, pa3); SBAR();
        SLOAD(SO, (j + 2) * KVBLK); SBAR();
        pv_d0(o, vb0, pa0, pa1, pa2, pa3); partialSM(pB0, pB1, m_reg, mnB, alB);
        __syncthreads(); SWRITE(0, SE);
        RESC(alB); __syncthreads();
        SBAR(); qkt(pA0, pA1, K_lds, qr, r32, hi);
        finishSM(pB0, pB1, alB, l_reg, pa0, pa1, pa2, pa3); SBAR();
        if (j + 3 < NT) SLOAD(SE, (j + 3) * KVBLK); SBAR();
        pv_d0(o, vb0 + SHM_V, pa0, pa1, pa2, pa3); partialSM(pA0, pA1, m_reg, mnA, alA);
        __syncthreads(); SWRITE(1, SO);
        RESC(alA); __syncthreads();
    }
    SBAR(); qkt(pB0, pB1, K_lds + SHM_K, qr, r32, hi);
    finishSM(pA0, pA1, alA, l_reg, pa0, pa1, pa2, pa3); SBAR();
    pv_d0(o, vb0, pa0, pa1, pa2, pa3); partialSM(pB0, pB1, m_reg, mnB, alB);
    __syncthreads(); RESC(alB);
    finishSM(pB0, pB1, alB, l_reg, pa0, pa1, pa2, pa3); SBAR();
    pv_d0(o, vb0 + SHM_V, pa0, pa1, pa2, pa3);
    if (hi == 0) li_l[r32] = l_reg; asm volatile("s_waitcnt lgkmcnt(0)" ::: "memory");
    float rli[16];
#pragma unroll
    for (int r = 0; r < 16; ++r) rli[r] = __builtin_amdgcn_rcpf(li_l[crow(r, hi)]);
    {
        bf16_t* stg = (bf16_t*)(lds + OFF_OST) + wid * 2048;
#pragma unroll
        for (int r = 0; r < 16; ++r) { const int orow = crow(r, hi);
#pragma unroll
            for (int d0 = 0; d0 < 2; ++d0) stg[orow * 64 + d0 * 32 + r32] = (bf16_t)(cvt_pk_bf16(o[d0][r] * rli[r], 0.f) & 0xffffu); }
        asm volatile("s_waitcnt lgkmcnt(0)" ::: "memory");
        bf16_t* Ow = Ob + (size_t)(wid * QBLK) * LDO;
#pragma unroll
        for (int i = 0; i < 4; ++i) { const int row = i * 8 + (lane >> 3), ch = lane & 7; const u32x4 v = *(const u32x4*)(stg + row * 64 + ch * 8); *(u32x4*)(Ow + (size_t)row * LDO + ch * 8) = v; }
    }
    __syncthreads();
#undef SLOAD
#undef SWRITE
#undef RESC
}
#undef KSWZ
#undef SBAR
}

#define XB_TMO      128
#define XB_XCNT(j)  (256  + 64 * (j))
#define XB_XSUB(j)  (1280 + 64 * (j))
#define XB_XGEN(j)  (2304 + 64 * (j))
#define XB_TOP      3328
#define XB_TOPGEN   3392
#define XCD_BAR_WORDS 3456
#define XB_SPIN_CAP (1u << 18)
__device__ __forceinline__ unsigned xb_ld(unsigned* p)              { return __hip_atomic_load(p, __ATOMIC_RELAXED, __HIP_MEMORY_SCOPE_AGENT); }
__device__ __forceinline__ unsigned xb_add(unsigned* p, unsigned v) { return __hip_atomic_fetch_add(p, v, __ATOMIC_RELAXED, __HIP_MEMORY_SCOPE_AGENT); }
__device__ __forceinline__ unsigned xb_xcc_id() { return (unsigned)__builtin_amdgcn_s_getreg((3 << 11) | 20) & 0xFu; }
#define XB_SPIN(cond, bar) do { unsigned _sp = 0; while (cond) { __builtin_amdgcn_s_sleep(1); \
    if ((++_sp & 255u) == 0u) { if (xb_ld(&(bar)[XB_TMO])) break; if (_sp > XB_SPIN_CAP) { atomicAdd(&(bar)[XB_TMO], 1u); break; } } } } while (0)
struct XcdBarrier { unsigned* bar; unsigned x; volatile LAS unsigned* st; };
__device__ __forceinline__ XcdBarrier xcd_barrier_post(unsigned* bar, volatile LAS unsigned* st) {
    XcdBarrier b; b.bar = bar; b.x = xb_xcc_id(); b.st = st;
    if (threadIdx.x == 0) (void)xb_add(&bar[XB_XCNT(b.x)], 1u);
    return b;
}
__device__ __forceinline__ void xcd_barrier_complete(unsigned* bar, unsigned x, unsigned& nloc, unsigned& nx) {
    const unsigned G = gridDim.x * gridDim.y * gridDim.z;
    unsigned sum, cnt, mine, sp = 0u;
    for (;;) {
        sum = 0u; cnt = 0u; mine = 0u;
#pragma unroll
        for (unsigned j = 0; j < 16; ++j) { const unsigned c = xb_ld(&bar[XB_XCNT(j)]); sum += c; cnt += (c > 0u) ? 1u : 0u; mine = (j == x) ? c : mine; }
        if (sum == G) break;
        __builtin_amdgcn_s_sleep(1);
        if ((++sp & 255u) == 0u) { if (xb_ld(&bar[XB_TMO])) break; if (sp > XB_SPIN_CAP) { atomicAdd(&bar[XB_TMO], 1u); break; } }
    }
    nloc = mine > 0u ? mine : 1u; nx = cnt > 0u ? cnt : 1u;
}
__device__ __forceinline__ void xcd_barrier(const XcdBarrier& b) {
    asm volatile("s_waitcnt vmcnt(0)" ::: "memory");
    __syncthreads();
    if (threadIdx.x == 0) {
        unsigned* bar = b.bar;
        __builtin_amdgcn_s_waitcnt(0);
        unsigned nloc = b.st[0], nx = b.st[1];
        if (nloc == 0u) { xcd_barrier_complete(bar, b.x, nloc, nx); b.st[0] = nloc; b.st[1] = nx; }
        const unsigned old = xb_add(&bar[XB_XSUB(b.x)], 1u);
        const unsigned gen = old / nloc;
        if (old + 1u == (gen + 1u) * nloc) {
            __builtin_amdgcn_fence(__ATOMIC_RELEASE, "agent");
            asm volatile("s_waitcnt vmcnt(0)" ::: "memory");
            const unsigned og = xb_add(&bar[XB_TOP], 1u);
            const unsigned tg = og / nx;
            if (og + 1u == (tg + 1u) * nx) xb_add(&bar[XB_TOPGEN], 1u);
            else XB_SPIN(xb_ld(&bar[XB_TOPGEN]) == tg, bar);
            __builtin_amdgcn_fence(__ATOMIC_ACQUIRE, "agent");
            xb_add(&bar[XB_XGEN(b.x)], 1u);
            asm volatile("s_waitcnt vmcnt(0)" ::: "memory");
        } else {
            XB_SPIN(xb_ld(&bar[XB_XGEN(b.x)]) == gen, bar);
            __builtin_amdgcn_fence(__ATOMIC_ACQUIRE, "agent");
            asm volatile("s_waitcnt vmcnt(0)" ::: "memory");
        }
    }
    __syncthreads();
}

constexpr int NWAVES = 8;
constexpr int MISC_OFF = 139264 + 64;
constexpr int LDS_BYTES = 147456;
struct Frame { LAS unsigned char* lds; int tid, lane, wave, vcu, G; float* out; unsigned char* ws; };
struct Args { const float* in[21]; float* out; unsigned char* ws; int st_lo, st_hi; };

template <class F> __device__ __forceinline__ void transpose_item(const F& f, int item, int nblk, bf16_t* dst, int ldd, LAS float* scr, int lane) {
    const int kb = item / nblk, nb = item % nblk, k0 = 64 * kb, n0 = 32 * nb;
#pragma unroll 8
    for (int i = 0; i < 32; ++i) { const int kk = 2 * i + (lane >> 5); scr[kk * 33 + (lane & 31)] = f(k0 + kk, n0 + (lane & 31)); }
    LDS_WAIT(); asm volatile("" ::: "memory");
    const int c = lane & 7;
#pragma unroll
    for (int j = 0; j < 4; ++j) { const int n = (lane >> 3) + 8 * j; const LAS float* s = scr + (8 * c) * 33 + n;
        u32x4 o; o.x = cvt_pk_bf16(s[0 * 33], s[1 * 33]); o.y = cvt_pk_bf16(s[2 * 33], s[3 * 33]); o.z = cvt_pk_bf16(s[4 * 33], s[5 * 33]); o.w = cvt_pk_bf16(s[6 * 33], s[7 * 33]);
        *(u32x4*)(dst + (size_t)(n0 + n) * ldd + k0 + 8 * c) = o; }
    LDS_WAIT(); asm volatile("" ::: "memory");
}
__device__ __forceinline__ int rope_perm(int p) { return (p >> 1) + 16 * (p & 1); }
struct SrcWz { const float* w; __device__ __forceinline__ float operator()(int k, int n) const {
    if (n < 640) return w[(size_t)k * INW + n]; if (n < 672) return w[(size_t)k * INW + 640 + rope_perm(n - 640)]; return 0.f; } };
struct SrcPlain { const float* w; int ld, coff; __device__ __forceinline__ float operator()(int k, int n) const { return w[(size_t)k * ld + coff + n]; } };
struct SrcGain { const float* w; const float* g; int ld; float sc; __device__ __forceinline__ float operator()(int k, int n) const { return w[(size_t)k * ld + n] * g[k] * sc; } };
struct SrcUq { const float* w; const float* g; __device__ __forceinline__ float operator()(int k, int n) const {
    const int h = n / DQK, e = n % DQK; const int src = h * DQK + (e < DN ? e : DN + rope_perm(e - DN)); return w[(size_t)k * 768 + src] * g[k] * QSCALE; } };
struct SrcGu { const float* w; const float* g; __device__ __forceinline__ float operator()(int k, int n) const {
    const int t = n >> 8, j = n & 255; const int src = (j < 128) ? (128 * t + j) : (DFF + 128 * t + (j - 128)); return w[(size_t)k * (2 * DFF) + src] * g[k]; } };

__constant__ double ROPE_INV[16] = {1.0, 0.5623413251903491, 0.31622776601683794, 0.1778279410038923, 0.1, 0.05623413251903491, 0.03162277660168379, 0.01778279410038923,
                                    0.01, 0.005623413251903491, 0.0031622776601683794, 0.0017782794100389228, 0.001, 0.0005623413251903491, 0.00031622776601683794, 0.00017782794100389227};

__device__ __forceinline__ void rms_row_to_bf16(const float* xrow, const f32x4 (&g)[4], bf16_t* orow, int lane) {
    const f32x4* xr = (const f32x4*)xrow + lane;
    f32x4 v[4]; float s = 0.f;
#pragma unroll
    for (int j = 0; j < 4; ++j) { v[j] = xr[64 * j]; s += (v[j][0] * v[j][0] + v[j][1] * v[j][1]) + (v[j][2] * v[j][2] + v[j][3] * v[j][3]); }
    const float r = __builtin_amdgcn_rsqf(wave_sum(s) * (1.f / DM) + EPS);
    u32x2* o8 = (u32x2*)orow + lane;
#pragma unroll
    for (int j = 0; j < 4; ++j) { const f32x4 y = v[j] * g[j] * r; u32x2 w; w.x = cvt_pk_bf16(y[0], y[1]); w.y = cvt_pk_bf16(y[2], y[3]); o8[64 * j] = w; }
}

__device__ __forceinline__ void p0_prologue(Frame& F, const Args& AR) {
    unsigned char* ws = F.ws; unsigned char* dob = (unsigned char*)F.out;
    bf16_t* WzT = (bf16_t*)(ws + WS_WZT); bf16_t* WfT = (bf16_t*)(ws + WS_WFT); bf16_t* WxkT = (bf16_t*)(ws + WS_WXKT); bf16_t* WxvT = (bf16_t*)(ws + WS_WXVT);
    bf16_t* WuqT = (bf16_t*)(ws + WS_WUQT); bf16_t* WukvT = (bf16_t*)(ws + WS_WUKVT); bf16_t* DFTM = (bf16_t*)(ws + WS_DFTM); bf16_t* WoutT = (bf16_t*)(ws + WS_WOUTT);
    bf16_t* WxqT = (bf16_t*)(ws + WS_WXQT); bf16_t* WxoT = (bf16_t*)(ws + WS_WXOT); bf16_t* WguT = (bf16_t*)(ws + WS_WGUT); bf16_t* WdT = (bf16_t*)(ws + WS_WDT);
    float* ropeC = (float*)(ws + WS_ROPEC); float* ropeS = (float*)(ws + WS_ROPES);
    bf16_t* XN = (bf16_t*)(ws + WS_R0); bf16_t* MN = (bf16_t*)(dob + DO_MN);
    const int gw = F.vcu * NWAVES + F.wave, NGW = F.G * NWAVES, gt = F.vcu * 512 + F.tid, NGT = F.G * 512;
    for (int it = F.vcu; it < 256; it += F.G) {
        const int g = it >> 6, k0 = (it & 63) * 16; LAS float* Wl = (LAS float*)F.lds;
#pragma unroll
        for (int e = 0; e < 4; ++e) { const int idx = F.tid + 512 * e; Wl[idx] = AR.in[5][(size_t)(k0 + (idx >> 7)) * INW + 672 + g * 128 + (idx & 127)]; }
        LDS_WAIT(); __syncthreads();
        const int nl = F.tid & 255, cs = nl >> 7, j = nl & 127, kh = F.tid >> 8; float a[8];
#pragma unroll
        for (int e = 0; e < 8; ++e) a[e] = 0.f;
        for (int c = 0; c < 128; ++c) { const float ph = (float)((j * c) & 127) * (1.0f / 128.0f); const float tv = cs ? __builtin_amdgcn_sinf(ph) : __builtin_amdgcn_cosf(ph);
#pragma unroll
            for (int e = 0; e < 8; ++e) a[e] += Wl[(kh * 8 + e) * 128 + c] * tv; }
        u32x4 o; o.x = cvt_pk_bf16(a[0], a[1]); o.y = cvt_pk_bf16(a[2], a[3]); o.z = cvt_pk_bf16(a[4], a[5]); o.w = cvt_pk_bf16(a[6], a[7]);
        *(u32x4*)(WfT + (size_t)(cs * 512 + g * 128 + j) * 1024 + k0 + kh * 8) = o;
        __syncthreads();
    }
    for (int it = F.vcu; it < 128; it += F.G) {
        const int g = it >> 5, n0 = (it & 31) * 32; LAS float* Wf = (LAS float*)F.lds; LAS float* Wo = (LAS float*)(F.lds + 65536);
#pragma unroll 8
        for (int e = 0; e < 32; ++e) { const int idx = F.tid + 512 * e; Wf[idx] = AR.in[10][(size_t)g * 16384 + idx]; }
#pragma unroll
        for (int e = 0; e < 8; ++e) { const int idx = F.tid + 512 * e; Wo[idx] = AR.in[11][(size_t)(512 + g * 128 + (idx >> 5)) * DM + n0 + (idx & 31)]; }
        LDS_WAIT(); __syncthreads();
        const int n = F.tid & 31, grp = F.tid >> 5; float a[8];
#pragma unroll
        for (int e = 0; e < 8; ++e) a[e] = 0.f;
        for (int c = 0; c < 128; ++c) { const float wv = Wo[c * 32 + n];
#pragma unroll
            for (int e = 0; e < 8; ++e) a[e] += Wf[(grp * 8 + e) * 128 + c] * wv; }
        u32x4 o; o.x = cvt_pk_bf16(a[0], a[1]); o.y = cvt_pk_bf16(a[2], a[3]); o.z = cvt_pk_bf16(a[4], a[5]); o.w = cvt_pk_bf16(a[6], a[7]);
        *(u32x4*)(WoutT + (size_t)(n0 + n) * 1024 + 512 + g * 128 + grp * 8) = o;
        __syncthreads();
    }
    {
        LAS float* scr = (LAS float*)(F.lds + F.wave * 16384);
        constexpr int I_WZ = 16 * 24, I_XK = 16 * 32, I_XV = 16 * 32, I_UQ = 6 * 24, I_UKV = 4 * 32, I_OUT = 8 * 32, I_XQ = 16 * 32, I_XO = 16 * 32, I_GU = 16 * 176, I_D = 44 * 32;
        constexpr int NITEMS = I_WZ + I_XK + I_XV + I_UQ + I_UKV + I_OUT + I_XQ + I_XO + I_GU + I_D;
        for (int it = gw; it < NITEMS; it += NGW) {
            int r = it;
            if (r < I_WZ) { transpose_item(SrcWz{AR.in[5]}, r, 24, WzT, 1024, scr, F.lane); continue; } r -= I_WZ;
            if (r < I_XK) { transpose_item(SrcPlain{AR.in[15], 2048, 0}, r, 32, WxkT, 1024, scr, F.lane); continue; } r -= I_XK;
            if (r < I_XV) { transpose_item(SrcPlain{AR.in[15], 2048, 1024}, r, 32, WxvT, 1024, scr, F.lane); continue; } r -= I_XV;
            if (r < I_UQ) { transpose_item(SrcUq{AR.in[7], AR.in[6]}, r, 24, WuqT, QL, scr, F.lane); continue; } r -= I_UQ;
            if (r < I_UKV) { transpose_item(SrcGain{AR.in[9], AR.in[8], 1024, 1.f}, r, 32, WukvT, KVL, scr, F.lane); continue; } r -= I_UKV;
            if (r < I_OUT) { transpose_item(SrcPlain{AR.in[11], 1024, 0}, r, 32, WoutT, 1024, scr, F.lane); continue; } r -= I_OUT;
            if (r < I_XQ) { transpose_item(SrcGain{AR.in[14], AR.in[12], 1024, XSCALE}, r, 32, WxqT, 1024, scr, F.lane); continue; } r -= I_XQ;
            if (r < I_XO) { transpose_item(SrcPlain{AR.in[16], 1024, 0}, r, 32, WxoT, 1024, scr, F.lane); continue; } r -= I_XO;
            if (r < I_GU) { transpose_item(SrcGu{AR.in[18], AR.in[17]}, r, 176, WguT, 1024, scr, F.lane); continue; } r -= I_GU;
            transpose_item(SrcPlain{AR.in[19], 1024, 0}, r, 32, WdT, DFF, scr, F.lane);
        }
    }
    for (int ch = gt; ch < 2 * 1024 * 128; ch += NGT) { const int mat = ch >> 17, r = (ch >> 7) & 1023, c0 = (ch & 127) * 8; float v[8];
#pragma unroll
        for (int e = 0; e < 8; ++e) { const int cc = c0 + e, sx = cc & 511; const float ph = mat ? (float)(((2 * r + 1) * sx) & 2047) * (1.0f / 2048.0f) : (float)((r * sx) & 1023) * (1.0f / 1024.0f);
            v[e] = (cc < 512 ? __builtin_amdgcn_cosf(ph) : -__builtin_amdgcn_sinf(ph)) * (1.0f / 512.0f); }
        u32x4 o; o.x = cvt_pk_bf16(v[0], v[1]); o.y = cvt_pk_bf16(v[2], v[3]); o.z = cvt_pk_bf16(v[4], v[5]); o.w = cvt_pk_bf16(v[6], v[7]);
        *(u32x4*)(DFTM + (size_t)mat * (1024 * 1024) + (size_t)r * 1024 + c0) = o; }
    for (int idx = gt; idx < SEQ * 16; idx += NGT) { const int s = idx >> 4, i = idx & 15; const double rev = (double)s * ROPE_INV[i] * 0.15915494309189535; const float ph = (float)(rev - __builtin_floor(rev));
        ropeC[idx] = __builtin_amdgcn_cosf(ph); ropeS[idx] = __builtin_amdgcn_sinf(ph); }
    {
        bf16_t* XF = (bf16_t*)(ws + WS_XF); bf16_t* XL = (bf16_t*)(ws + WS_XL);
        f32x4 g[4];
#pragma unroll
        for (int j = 0; j < 4; ++j) g[j] = *((const f32x4*)AR.in[4] + F.lane + 64 * j);
        for (int task = gw; task < NB * 513; task += NGW) {
            const int b = task / 513, sx = task - b * 513; const int base = b * SEQ;
            const float* xb = (b < NBP) ? AR.in[0] + (size_t)base * DM : AR.in[1] + (size_t)(base - TP) * DM;
            if (sx == 0 || sx == 512) {
                f32x4 v[2][4];
#pragma unroll
                for (int q = 0; q < 2; ++q) { const int row = sx + q * 1024; const f32x4* xr = (const f32x4*)(xb + (size_t)row * DM) + F.lane; float ss = 0.f;
#pragma unroll
                    for (int j = 0; j < 4; ++j) { v[q][j] = xr[64 * j]; ss += (v[q][j][0] * v[q][j][0] + v[q][j][1] * v[q][j][1]) + (v[q][j][2] * v[q][j][2] + v[q][j][3] * v[q][j][3]); }
                    const float r = __builtin_amdgcn_rsqf(wave_sum(ss) * (1.f / DM) + EPS); u32x2* o8 = (u32x2*)(XN + (size_t)(base + row) * DM) + F.lane;
#pragma unroll
                    for (int j = 0; j < 4; ++j) { v[q][j] = v[q][j] * g[j] * r; u32x2 w; w.x = cvt_pk_bf16(v[q][j][0], v[q][j][1]); w.y = cvt_pk_bf16(v[q][j][2], v[q][j][3]); o8[64 * j] = w; } }
                u32x2* oA = (sx == 0) ? (u32x2*)(XF + (size_t)(base + 0 * 512) * DM) + F.lane : (u32x2*)(XL + (size_t)(0 * 256 + b) * DM) + F.lane;
                u32x2* oB = (sx == 0) ? (u32x2*)(XF + (size_t)(base + 2 * 512) * DM) + F.lane : (u32x2*)(XL + (size_t)(1 * 256 + b) * DM) + F.lane;
#pragma unroll
                for (int j = 0; j < 4; ++j) { const f32x4 sA = v[0][j] + v[1][j], sB = v[0][j] - v[1][j]; u32x2 w; w.x = cvt_pk_bf16(sA[0], sA[1]); w.y = cvt_pk_bf16(sA[2], sA[3]); oA[64 * j] = w;
                    w.x = cvt_pk_bf16(sB[0], sB[1]); w.y = cvt_pk_bf16(sB[2], sB[3]); oB[64 * j] = w; }
                if (sx == 0) { u32x2* z1 = (u32x2*)(XF + (size_t)(base + 1 * 512) * DM) + F.lane; u32x2* z3 = (u32x2*)(XF + (size_t)(base + 3 * 512) * DM) + F.lane; const u32x2 zz = {0u, 0u};
#pragma unroll
                    for (int j = 0; j < 4; ++j) { z1[64 * j] = zz; z3[64 * j] = zz; } }
            } else {
                f32x4 v[4][4];
#pragma unroll
                for (int q = 0; q < 4; ++q) { const int row = (q == 0) ? sx : (q == 1) ? sx + 1024 : (q == 2) ? 1024 - sx : 2048 - sx; const f32x4* xr = (const f32x4*)(xb + (size_t)row * DM) + F.lane; float ss = 0.f;
#pragma unroll
                    for (int j = 0; j < 4; ++j) { v[q][j] = xr[64 * j]; ss += (v[q][j][0] * v[q][j][0] + v[q][j][1] * v[q][j][1]) + (v[q][j][2] * v[q][j][2] + v[q][j][3] * v[q][j][3]); }
                    const float r = __builtin_amdgcn_rsqf(wave_sum(ss) * (1.f / DM) + EPS); u32x2* o8 = (u32x2*)(XN + (size_t)(base + row) * DM) + F.lane;
#pragma unroll
                    for (int j = 0; j < 4; ++j) { v[q][j] = v[q][j] * g[j] * r; u32x2 w; w.x = cvt_pk_bf16(v[q][j][0], v[q][j][1]); w.y = cvt_pk_bf16(v[q][j][2], v[q][j][3]); o8[64 * j] = w; } }
                u32x2* o0 = (u32x2*)(XF + (size_t)(base + 0 * 512 + sx) * DM) + F.lane; u32x2* o1 = (u32x2*)(XF + (size_t)(base + 1 * 512 + sx) * DM) + F.lane;
                u32x2* o2 = (u32x2*)(XF + (size_t)(base + 2 * 512 + sx) * DM) + F.lane; u32x2* o3 = (u32x2*)(XF + (size_t)(base + 3 * 512 + sx) * DM) + F.lane;
#pragma unroll
                for (int j = 0; j < 4; ++j) { const f32x4 ab = v[0][j] + v[1][j], cd = v[2][j] + v[3][j], amb = v[0][j] - v[1][j], cmd = v[2][j] - v[3][j];
                    const f32x4 ec = ab + cd, es = ab - cd, oc = amb - cmd, os = amb + cmd; u32x2 w;
                    w.x = cvt_pk_bf16(ec[0], ec[1]); w.y = cvt_pk_bf16(ec[2], ec[3]); o0[64 * j] = w;
                    w.x = cvt_pk_bf16(es[0], es[1]); w.y = cvt_pk_bf16(es[2], es[3]); o1[64 * j] = w;
                    w.x = cvt_pk_bf16(oc[0], oc[1]); w.y = cvt_pk_bf16(oc[2], oc[3]); o2[64 * j] = w;
                    w.x = cvt_pk_bf16(os[0], os[1]); w.y = cvt_pk_bf16(os[2], os[3]); o3[64 * j] = w; }
            }
        }
        for (int rr = gw; rr < 2 * 232; rr += NGW) { const int ty = rr / 232, row = 24 + rr % 232; u32x2* z = (u32x2*)(XL + (size_t)(ty * 256 + row) * DM) + F.lane; const u32x2 zz = {0u, 0u};
#pragma unroll
            for (int j = 0; j < 4; ++j) z[64 * j] = zz; }
#pragma unroll
        for (int j = 0; j < 4; ++j) g[j] = *((const f32x4*)AR.in[13] + F.lane + 64 * j);
        for (int m = gw; m < TMEM; m += NGW) rms_row_to_bf16(m < TMP ? AR.in[2] + (size_t)m * DM : AR.in[3] + (size_t)(m - TMP) * DM, g, MN + (size_t)m * DM, F.lane);
    }
}

__device__ __forceinline__ void final_norm(Frame& F, const Args& AR) {
    const float* PS = (const float*)(F.ws + WS_PS); const bf16_t* XB = (const bf16_t*)(F.ws + WS_R1);
    const int gw = F.vcu * NWAVES + F.wave, NGW = F.G * NWAVES;
    f32x4 g[4];
#pragma unroll
    for (int j = 0; j < 2; ++j) { g[2 * j] = *(const f32x4*)(AR.in[20] + j * 512 + 8 * F.lane); g[2 * j + 1] = *(const f32x4*)(AR.in[20] + j * 512 + 8 * F.lane + 4); }
    for (int m = gw; m < T; m += NGW) {
        const float pv = (F.lane < 16) ? PS[(size_t)m * 16 + F.lane] : 0.f;
        const float r = __builtin_amdgcn_rsqf(wave_sum(pv) * (1.f / DM) + EPS);
#pragma unroll
        for (int j = 0; j < 2; ++j) { const u32x4 w = *(const u32x4*)(XB + (size_t)m * DM + j * 512 + 8 * F.lane);
            const f32x4 y0 = (f32x4){__uint_as_float(w.x << 16), __uint_as_float(w.x & 0xffff0000u), __uint_as_float(w.y << 16), __uint_as_float(w.y & 0xffff0000u)};
            const f32x4 y1 = (f32x4){__uint_as_float(w.z << 16), __uint_as_float(w.z & 0xffff0000u), __uint_as_float(w.w << 16), __uint_as_float(w.w & 0xffff0000u)};
            float* o = F.out + (size_t)m * DM + j * 512 + 8 * F.lane;
            *(f32x4*)o = y0 * g[2 * j] * r; *(f32x4*)(o + 4) = y1 * g[2 * j + 1] * r; }
    }
}

constexpr int NSTEPS = 12;
__global__ void __launch_bounds__(NWAVES * 64, 2) fwd_kernel(Args args) {
    extern __shared__ __attribute__((aligned(16))) unsigned char lds_raw[];
    Frame F;
    F.lds = (LAS unsigned char*)lds_raw;
    F.tid = threadIdx.x; F.lane = F.tid & 63; F.wave = __builtin_amdgcn_readfirstlane(F.tid >> 6);
    F.G = GRID; { const int bx = blockIdx.x; F.vcu = (bx % 8) * (GRID / 8) + bx / 8; }
    F.out = args.out; F.ws = args.ws;
    volatile LAS unsigned* MISC = (volatile LAS unsigned*)(F.lds + MISC_OFF);
    if (F.tid < 32) MISC[F.tid] = 0u;
    __syncthreads();
    unsigned* ctl = (unsigned*)(F.ws + WS_CTL);
    XcdBarrier bar; bar.bar = ctl + CW_BAR; bar.x = 0; bar.st = nullptr;
    const int lo = args.st_lo, hi = args.st_hi;
    if (hi - lo > 1) bar = xcd_barrier_post(ctl + CW_BAR, MISC + 8);
#ifndef PH_MASK
#define PH_MASK 0xfff
#endif
#define IN(k) (((PH_MASK >> (k)) & 1) && lo <= (k) && (k) < hi)
#define SEAM(k) do { if (IN(k) && IN((k) + 1)) xcd_barrier(bar); } while (0)
#define MIB(x) ((int)((x) / MiB))
#ifndef REPEAT_PH
#define REPEAT_PH -1
#endif
#define TWICE(k, ...) do { __VA_ARGS__ if (REPEAT_PH == (k)) { xcd_barrier(bar); __VA_ARGS__ } } while (0)
    unsigned char* ws = F.ws; unsigned char* dob = (unsigned char*)F.out;
    Epi E; E.ws = ws; E.out = F.out; E.xp = nullptr; E.xs = nullptr;
    if (IN(0)) TWICE(0, { p0_prologue(F, args); }); SEAM(0);
    if (IN(1)) TWICE(1, { Sched<SK_P1, 0, 1024, 1024> S{(const char*)ws, (const char*)dob}; gemm_phase<SK_P1, 0, 1024, 1024, 1024, EK_P1, 0>(F.lds, S, E); }); SEAM(1);
    if (IN(2)) TWICE(2, {
        { Sched<SK_GEN, 3, ZW, QL> S{(const char*)(dob + DO_Z), (const char*)(ws + WS_WUQT)}; gemm_phase<SK_GEN, 3, ZW, QL, QL, EK_Q, 0>(F.lds, S, E); }
        { Sched<SK_GEN, 4, ZW, KVL> S{(const char*)(dob + DO_Z) + QL * 2, (const char*)(ws + WS_WUKVT)}; gemm_phase<SK_GEN, 4, ZW, KVL, KVL, EK_KV, 0>(F.lds, S, E); }
    }); SEAM(2);
    if (IN(3)) {
        TWICE(30, { Sched<SK_DFT, 0, 1024, 1024> S{(const char*)(ws + WS_DFTM), (const char*)(ws + WS_R1)}; gemm_phase<SK_DFT, 0, 1024, 1024, 1024, EK_DFT, MIB(WS_R0)>(F.lds, S, E); });
        const int c = (int)blockIdx.x, x = c & 7, j = c >> 3;
        const int nun = 6;
        const bf16_t* Qb = (const bf16_t*)(dob + DO_Q); const bf16_t* Kfb = (const bf16_t*)(ws + WS_KF); const bf16_t* Vb = (const bf16_t*)(ws + WS_V); bf16_t* Y = (bf16_t*)(ws + WS_R0);
        TWICE(31, {for (int r = 0; r < nun; ++r) {
            const int uidx = j + 32 * r;
            const int bh = x * 24 + (uidx >> 3), qb = uidx & 7, b = bh >> 3, h = bh & 7;
            const size_t row0 = (size_t)b * SEQ;
            mla::attn_unit(Qb + (row0 + qb * 256) * 768 + h * DQK, Kfb + row0 * 768 + h * DQK, Vb + row0 * 512 + h * DVH, Y + (row0 + qb * 256) * 1024 + h * DVH, (char*)lds_raw);
        } });
    } SEAM(3);
    if (IN(4)) TWICE(4, { Epi E4 = E; E4.xp = args.in[0]; E4.xs = args.in[1];
        Sched<SK_GEN, 4, 1024, 1024> S{(const char*)(ws + WS_R0), (const char*)(ws + WS_WOUTT)}; gemm_phase<SK_GEN, 4, 1024, 1024, 1024, EK_RES_X, MIB(WS_R1)>(F.lds, S, E4); }); SEAM(4);
    if (IN(5)) TWICE(5, { Sched<SK_GEN, 4, 1024, 1024> S{(const char*)(ws + WS_R1), (const char*)(ws + WS_WXQT)}; gemm_phase<SK_GEN, 4, 1024, 1024, 1024, EK_ROWSCALE, MIB(WS_R0)>(F.lds, S, E); }); SEAM(5);
    if (IN(6)) TWICE(6, { Sched<SK_XS, 4, 1024, 1024> S{(const char*)(ws + WS_R0), (const char*)(ws + WS_KX)}; gemm_phase<SK_XS, 4, 1024, 1024, 256, EK_SOFTMAX, MIB(WS_R2)>(F.lds, S, E); }); SEAM(6);
    if (IN(7)) TWICE(7, { Sched<SK_XPV, 4, 1024, 256> S{(const char*)(ws + WS_R2), (const char*)(ws + WS_VXT)}; gemm_phase<SK_XPV, 4, 1024, 256, 256, EK_PLAIN, MIB(WS_R0)>(F.lds, S, E); }); SEAM(7);
    if (IN(8)) { Sched<SK_GEN, 4, 1024, 1024> S{(const char*)(ws + WS_R0), (const char*)(ws + WS_WXOT)}; gemm_phase<SK_GEN, 4, 1024, 1024, 1024, EK_RES, MIB(WS_R1)>(F.lds, S, E); } SEAM(8);
    if (IN(9)) TWICE(9, { Sched<SK_GEN, 22, 1024, 1024> S{(const char*)(ws + WS_R1), (const char*)(ws + WS_WGUT)}; gemm_phase<SK_GEN, 22, 1024, 1024, 1024, EK_SWIGLU, MIB(WS_H)>(F.lds, S, E); }); SEAM(9);
    if (IN(10)) { Sched<SK_GEN, 4, DFF, DFF> S{(const char*)(ws + WS_H), (const char*)(ws + WS_WDT)}; gemm_phase<SK_GEN, 4, DFF, DFF, DFF, EK_RES_NOB, 0>(F.lds, S, E); } SEAM(10);
    if (IN(11)) { final_norm(F, args); }
#undef IN
#undef SEAM
#undef MIB
}

extern "C" void kernel_launch(void* const* d_in, const int* in_sizes, int n_in, void* d_out, int out_size, void* d_ws, size_t ws_size, hipStream_t stream) {
    static int grid = 0;
    if (grid == 0) {
        if (n_in != 21 || in_sizes[0] != TP * DM || in_sizes[1] != (T - TP) * DM || out_size != T * DM || ws_size < WS_END) {
            fprintf(stderr, "kernel_launch: unexpected shapes (n_in %d, in0 %d, out %d, ws %zu); nothing launched\n", n_in, n_in > 0 ? in_sizes[0] : -1, out_size, ws_size); grid = -1; return; }
        int dev = 0, cus = 0, per_cu = 0;
        if (hipGetDevice(&dev) != hipSuccess || hipDeviceGetAttribute(&cus, hipDeviceAttributeMultiprocessorCount, dev) != hipSuccess) { grid = -1; return; }
        if (hipFuncSetAttribute((const void*)fwd_kernel, hipFuncAttributeMaxDynamicSharedMemorySize, LDS_BYTES) != hipSuccess) { fprintf(stderr, "kernel_launch: hipFuncSetAttribute failed\n"); grid = -1; return; }
        if (hipOccupancyMaxActiveBlocksPerMultiprocessor(&per_cu, (const void*)fwd_kernel, NWAVES * 64, LDS_BYTES) != hipSuccess || per_cu < 1) { fprintf(stderr, "kernel_launch: occupancy query says %d blocks/CU\n", per_cu); grid = -1; (void)hipGetLastError(); return; }
        (void)hipGetLastError();
        if (cus != 256) { fprintf(stderr, "kernel_launch: built for 256 CUs, device has %d\n", cus); grid = -1; return; }
        grid = cus;
    }
    if (grid < 0) return;
    (void)hipMemsetAsync((char*)d_ws + WS_CTL, 0, CTL_ZERO_BYTES, stream);
    Args a{};
    for (int i = 0; i < 21; ++i) a.in[i] = (const float*)d_in[i];
    a.out = (float*)d_out; a.ws = (unsigned char*)d_ws;
#if DBG_STEPS
    for (int st = 0; st < NSTEPS; ++st) { a.st_lo = st; a.st_hi = st + 1; hipLaunchKernelGGL(fwd_kernel, dim3(grid), dim3(NWAVES * 64), LDS_BYTES, stream, a); }
#else
    a.st_lo = 0; a.st_hi = NSTEPS;
    hipLaunchKernelGGL(fwd_kernel, dim3(grid), dim3(NWAVES * 64), LDS_BYTES, stream, a);
#endif
}
```

```cpp
#include <hip/hip_runtime.h>
#include <cstdio>
#include <cstdint>

#define LAS __attribute__((address_space(3)))
#define GAS __attribute__((address_space(1)))
typedef unsigned short bf16_t;
typedef short bf16x8 __attribute__((ext_vector_type(8)));
typedef short s16x4 __attribute__((ext_vector_type(4)));
typedef float f32x4 __attribute__((ext_vector_type(4)));
typedef float f32x2 __attribute__((ext_vector_type(2)));
typedef float f32x16 __attribute__((ext_vector_type(16)));
typedef unsigned u32x4 __attribute__((ext_vector_type(4)));
typedef unsigned u32x2 __attribute__((ext_vector_type(2)));

#ifndef DBG_STEPS
#define DBG_STEPS 0
#endif

constexpr int DM = 1024, SEQ = 2048, NB = 24, NBP = 16, T = NB * SEQ, TP = NBP * SEQ;
constexpr int MEML = 256, TMEM = NB * MEML, TMP = NBP * MEML;
constexpr int QL = 384, KVL = 256, DR = 32, FW = 512, INW = 1184;
constexpr int NH = 8, DN = 64, DVH = 64, DQK = 96;
constexpr int ZW = 768;
constexpr int DFF = 2816;
constexpr float EPS = 1e-6f;
constexpr float LOG2E = 1.4426950408889634f;
constexpr float QSCALE = 0.10206207261596577f * LOG2E;
constexpr float XSCALE = 0.0625f * LOG2E;

constexpr size_t MiB = 1u << 20;
constexpr size_t WS_CTL = 0, CTL_ZERO_BYTES = 65536;
constexpr size_t WS_WZT = 1 * MiB, WS_WFT = 3 * MiB, WS_WXKT = 5 * MiB, WS_WXVT = 7 * MiB, WS_WUQT = 9 * MiB, WS_WUKVT = 10 * MiB;
constexpr size_t WS_ROPEC = 11 * MiB, WS_ROPES = 11 * MiB + 128 * 1024;
constexpr size_t WS_DFTM = 12 * MiB, WS_WOUTT = 28 * MiB, WS_WXQT = 30 * MiB, WS_WXOT = 32 * MiB, WS_WGUT = 34 * MiB, WS_WDT = 45 * MiB;
constexpr size_t WS_R0 = 52 * MiB;
constexpr size_t WS_R1 = 148 * MiB;
constexpr size_t WS_R2 = 244 * MiB;
constexpr size_t WS_KF = WS_R2, WS_V = WS_R2 + 72 * MiB, WS_KX = WS_R2 + 120 * MiB, WS_VXT = WS_R2 + 132 * MiB, WS_H = WS_R2;
constexpr size_t WS_XF = 388 * MiB;
constexpr size_t WS_XL = 484 * MiB;
constexpr size_t WS_EQDQ = 485 * MiB;
constexpr size_t WS_PS = 508 * MiB;
constexpr size_t WS_END = 511 * MiB;
constexpr size_t DO_Z = 0, DO_MN = 72 * MiB, DO_PS1 = 84 * MiB, DO_Q = 96 * MiB;
constexpr int CW_BAR = 4096;

__device__ __forceinline__ unsigned cvt_pk_bf16(float lo, float hi) { unsigned r; asm volatile("v_cvt_pk_bf16_f32 %0, %1, %2" : "=v"(r) : "v"(lo), "v"(hi)); return r; }
__device__ __forceinline__ u32x4 pack8(f32x4 a, f32x4 b) { u32x4 w; w.x = cvt_pk_bf16(a[0], a[1]); w.y = cvt_pk_bf16(a[2], a[3]); w.z = cvt_pk_bf16(b[0], b[1]); w.w = cvt_pk_bf16(b[2], b[3]); return w; }
__device__ __forceinline__ float bf2f(bf16_t v) { return __uint_as_float(((unsigned)v) << 16); }
__device__ __forceinline__ float sumsq8(f32x4 a, f32x4 b) { return (a[0] * a[0] + a[1] * a[1]) + (a[2] * a[2] + a[3] * a[3]) + (b[0] * b[0] + b[1] * b[1]) + (b[2] * b[2] + b[3] * b[3]); }
__device__ __forceinline__ float fq_sum(float v) { v += __shfl_xor(v, 16); v += __shfl_xor(v, 32); return v; }
__device__ __forceinline__ float fq_max(float v) { v = fmaxf(v, __shfl_xor(v, 16)); v = fmaxf(v, __shfl_xor(v, 32)); return v; }
__device__ __forceinline__ float wave_sum(float v) {
#pragma unroll
    for (int o = 1; o < 64; o <<= 1) v += __shfl_xor(v, o);
    return v;
}
#define LDS_WAIT() asm volatile("s_waitcnt lgkmcnt(0)" ::: "memory")
#define VM_WAIT() asm volatile("s_waitcnt vmcnt(0)" ::: "memory")

namespace pg8 {
constexpr int BM = 256, BK = 64, HALF = 128, HTB = HALF * BK * 2, STAGE_BYTES = 8 * HTB;
__host__ __device__ __forceinline__ int lds_byte(int r, int c) { const int st = (r >> 4) * 2 + (c >> 5), rr = r & 15, cc = c & 31, ob = rr * 64 + cc * 2; return st * 1024 + (ob ^ (((ob >> 9) & 1) << 5)); }
__host__ __device__ __forceinline__ void stage_rc(int b, int& R, int& C) { const int st = b / 1024, sb = b % 1024, swz = sb ^ (((sb >> 9) & 1) << 5); R = (st >> 1) * 16 + swz / 64; C = (st & 1) * 32 + (swz % 64) / 2; }
__host__ __device__ __forceinline__ int perm32(int rho) { const int n = rho >> 4, i = rho & 15; return 8 * (i >> 2) + 4 * n + (i & 3); }
struct Unit { int pm, pn, ty; const char* a; const char* b; };
}
using pg8::Unit;

enum { SK_GEN = 0, SK_P1 = 1, SK_XS = 2, SK_XPV = 3, SK_DFT = 4 };
constexpr int GRID = 256;
__device__ __forceinline__ bool tile_of(int L, int nM, int nN, int& pm, int& pn) {
    const int nwg = nM * nN; if (L >= nwg || L < 0) return false;
    const int q = nwg / 8, r = nwg % 8, xcd = L % 8, off = L / 8;
    const int wgid = (xcd < r ? xcd * (q + 1) : r * (q + 1) + (xcd - r) * q) + off;
    const int nig = 8 * nN, gid = wgid / nig, fm = gid * 8, gsz = (nM - fm) < 8 ? (nM - fm) : 8;
    pm = fm + ((wgid % nig) % gsz); pn = (wgid % nig) / gsz; return true;
}
template <int KIND, int NN, int LDA, int LDB>
struct Sched {
    const char* A; const char* B;
    __device__ __forceinline__ bool next(int i, Unit& u) const {
        const int c = (int)blockIdx.x; const int L = i * GRID + c;
        u.ty = 0;
        if constexpr (KIND == SK_GEN) {
            if (!tile_of(L, 192, NN, u.pm, u.pn)) return false;
            u.a = A + (size_t)u.pm * ((size_t)512 * LDA); u.b = B + (size_t)u.pn * ((size_t)512 * LDB); return true;
        } else if constexpr (KIND == SK_P1) {
            constexpr size_t TS = (size_t)256 * 1024 * 2; const char* ws = A; const char* dob = B;
            if (L < 384) { tile_of(L, 2, 192, u.pm, u.pn); u.ty = 0; u.a = ws + WS_WFT + (size_t)(((u.pn >> 1) & 1) * 2 + u.pm) * TS; u.b = ws + WS_XF + u.pn * TS; return true; }
            if (L < 960) { tile_of(L - 384, 192, 3, u.pm, u.pn); u.ty = 1; u.a = ws + WS_R0 + u.pm * TS; u.b = ws + WS_WZT + u.pn * TS; return true; }
            if (L < 1056) { tile_of(L - 960, 24, 4, u.pm, u.pn); u.ty = 2; u.a = dob + DO_MN + u.pm * TS; u.b = ws + WS_WXKT + u.pn * TS; return true; }
            if (L < 1152) { tile_of(L - 1056, 4, 24, u.pm, u.pn); u.ty = 3; u.a = ws + WS_WXVT + u.pm * TS; u.b = dob + DO_MN + u.pn * TS; return true; }
            if (L < 1156) { const int e = L - 1152; u.pm = e & 1; u.pn = e >> 1; u.ty = 4; u.a = ws + WS_WFT + (size_t)(u.pn * 2 + u.pm) * TS; u.b = ws + WS_XL + u.pn * TS; return true; }
            return false;
        } else if constexpr (KIND == SK_XS) {
            if (!tile_of(L, 192, 4, u.pm, u.pn)) return false;
            u.a = A + (size_t)u.pm * ((size_t)512 * 1024) + (size_t)u.pn * 512; u.b = B + (size_t)(u.pm >> 3) * ((size_t)256 * 2048) + (size_t)u.pn * 512; return true;
        } else if constexpr (KIND == SK_XPV) {
            if (!tile_of(L, 192, 4, u.pm, u.pn)) return false;
            u.a = A + (size_t)u.pm * ((size_t)512 * 1024) + (size_t)u.pn * 512; u.b = B + (size_t)((u.pm >> 3) * 4 + u.pn) * 131072; return true;
        } else {
            const int x = c & 7, j = c >> 3; if (i >= 2 || (i == 1 && j >= 16)) return false;
            const int w = j + 32 * i, bb = 3 * x + (w >> 4), e16 = w & 15, eo = e16 >> 3; u.pm = e16 & 3; u.pn = (e16 >> 2) & 1; u.ty = bb * 2 + eo;
            u.a = A + (size_t)eo * (2 * MiB) + (size_t)u.pm * ((size_t)256 * 1024 * 2); u.b = B + ((size_t)((bb * 2 + eo) * 512 + u.pn * 256)) * 1024 * 2; return true;
        }
    }
};

enum { EK_P1 = 0, EK_Q, EK_KV, EK_DFT, EK_RES_X, EK_RES, EK_RES_NOB, EK_ROWSCALE, EK_SOFTMAX, EK_PLAIN, EK_SWIGLU, EK_NONE, EK_SWIGLU_NOST };
struct Epi { unsigned char* ws; float* out; const float* xp; const float* xs; };
constexpr int LDS_SMX = 131072;

__device__ __forceinline__ void rows_r16(const float* PS, int row0, int fq, float (&r)[2][4]) {
    f32x4 p[2][4];
#pragma unroll
    for (int ai = 0; ai < 2; ++ai)
#pragma unroll
        for (int m = 0; m < 4; ++m) p[ai][m] = *(const f32x4*)(PS + (size_t)(row0 + ai * 128 + m * 16) * 16 + fq * 4);
#pragma unroll
    for (int ai = 0; ai < 2; ++ai)
#pragma unroll
        for (int m = 0; m < 4; ++m) r[ai][m] = __builtin_amdgcn_rsqf(fq_sum((p[ai][m][0] + p[ai][m][1]) + (p[ai][m][2] + p[ai][m][3])) * (1.0f / 1024.0f) + EPS);
}
__device__ __forceinline__ void rope_cs(int pos, int i0, f32x4& cs, f32x4& sn) {
#pragma unroll
    for (int e = 0; e < 4; ++e) { const float inv = __builtin_amdgcn_exp2f((float)(i0 + e) * (-0.8304820237218406f)) * 0.15915494309189535f;
        const float rev = (float)pos * inv; const float ph = rev - __builtin_floorf(rev); cs[e] = __builtin_amdgcn_cosf(ph); sn[e] = __builtin_amdgcn_sinf(ph); }
}
__device__ __forceinline__ void rope8(f32x4& v0, f32x4& v1, const f32x4 cs4, const f32x4 sn4) {
    f32x4 o0, o1;
    o0[0] = v0[0] * cs4[0] - v0[1] * sn4[0]; o0[1] = v0[1] * cs4[0] + v0[0] * sn4[0];
    o0[2] = v0[2] * cs4[1] - v0[3] * sn4[1]; o0[3] = v0[3] * cs4[1] + v0[2] * sn4[1];
    o1[0] = v1[0] * cs4[2] - v1[1] * sn4[2]; o1[1] = v1[1] * cs4[2] + v1[0] * sn4[2];
    o1[2] = v1[2] * cs4[3] - v1[3] * sn4[3]; o1[3] = v1[3] * cs4[3] + v1[2] * sn4[3];
    v0 = o0; v1 = o1;
}
#define EPI_ARGS const Epi& E, f32x4 (&acc)[2][2][4][2], const Unit& u, int wr, int wc, int fr, int fq, LAS unsigned char* lds
#define EPI_ROWS for (int ai = 0; ai < 2; ++ai) _Pragma("unroll") for (int m = 0; m < 4; ++m)
#define EPI_FENCE() asm volatile("" ::: "memory")

__device__ __forceinline__ void epi_p1(EPI_ARGS) {
    const int rl0 = wr * 64 + fr, cl0 = wc * 32 + 8 * fq;
    if (u.ty == 0) {
        bf16_t* UT2 = (bf16_t*)(E.ws + WS_R1);
#pragma unroll
        EPI_ROWS { const int n = u.pm * 256 + ai * 128 + m * 16 + rl0;
#pragma unroll
            for (int bj = 0; bj < 2; ++bj) { const int t = u.pn * 256 + bj * 128 + cl0; const int b = t >> 11, blk = (t >> 9) & 3, sidx = t & 511;
                *(u32x4*)(UT2 + ((size_t)((b * 2 + (blk >> 1)) * 512 + n)) * 1024 + (blk & 1) * 512 + sidx) = pack8(acc[ai][bj][m][0], acc[ai][bj][m][1]); } }
    } else if (u.ty == 4) {
        float* QD = (float*)(E.ws + WS_EQDQ);
        if (wc == 0 && fq < 3) {
#pragma unroll
            EPI_ROWS { const int n = u.pm * 256 + ai * 128 + m * 16 + rl0;
#pragma unroll
                for (int e = 0; e < 4; ++e) { QD[(size_t)(u.pn * 24 + 8 * fq + e) * 512 + n] = acc[ai][0][m][0][e]; QD[(size_t)(u.pn * 24 + 8 * fq + 4 + e) * 512 + n] = acc[ai][0][m][1][e]; } }
        }
    } else if (u.ty == 1) {
        bf16_t* Z = (bf16_t*)((unsigned char*)E.out + DO_Z); float* PS1 = (float*)((unsigned char*)E.out + DO_PS1); bf16_t* Kf = (bf16_t*)(E.ws + WS_KF);
#pragma unroll
        EPI_ROWS { const int row = u.pm * 256 + ai * 128 + m * 16 + rl0;
#pragma unroll
            for (int bj = 0; bj < 2; ++bj) { const int c = u.pn * 256 + bj * 128 + cl0; f32x4 v0 = acc[ai][bj][m][0], v1 = acc[ai][bj][m][1];
                *(u32x4*)(Z + (size_t)row * ZW + c) = pack8(v0, v1);
                const float ss = fq_sum(sumsq8(v0, v1)); const int half = u.pn * 2 + bj;
                if (half < 5 && fq == 0) PS1[(size_t)row * 24 + half * 4 + wc] = ss;
                if (half == 5 && wc == 0) {
                    const int pos = row & (SEQ - 1);
                    f32x4 cs4, sn4; rope_cs(pos, 4 * fq, cs4, sn4); rope8(v0, v1, cs4, sn4);
                    const u32x4 w = pack8(v0, v1);
#pragma unroll
                    for (int h = 0; h < NH; ++h) *(u32x4*)(Kf + (size_t)row * 768 + h * DQK + DN + 8 * fq) = w;
                } } }
    } else if (u.ty == 2) {
        bf16_t* Kx = (bf16_t*)(E.ws + WS_KX);
#pragma unroll
        EPI_ROWS { const int row = u.pm * 256 + ai * 128 + m * 16 + rl0;
#pragma unroll
            for (int bj = 0; bj < 2; ++bj) *(u32x4*)(Kx + (size_t)row * 1024 + u.pn * 256 + bj * 128 + cl0) = pack8(acc[ai][bj][m][0], acc[ai][bj][m][1]); }
    } else {
        bf16_t* VxT = (bf16_t*)(E.ws + WS_VXT);
#pragma unroll
        EPI_ROWS { const int d = ai * 128 + m * 16 + rl0;
#pragma unroll
            for (int bj = 0; bj < 2; ++bj) *(u32x4*)(VxT + ((size_t)((u.pn * 4 + u.pm) * 256 + d)) * 256 + bj * 128 + cl0) = pack8(acc[ai][bj][m][0], acc[ai][bj][m][1]); }
    }
}
__device__ __forceinline__ void epi_q(EPI_ARGS) {
    const int rl0 = wr * 64 + fr, cl0 = wc * 32 + 8 * fq;
    const float* PS1 = (const float*)((unsigned char*)E.out + DO_PS1); bf16_t* Q = (bf16_t*)((unsigned char*)E.out + DO_Q);
    float rr[2][4];
    { f32x4 p[2][4];
#pragma unroll
      EPI_ROWS { p[ai][m] = (f32x4){0.f, 0.f, 0.f, 0.f}; if (fq < 3) p[ai][m] = *(const f32x4*)(PS1 + (size_t)(u.pm * 256 + ai * 128 + m * 16 + rl0) * 24 + fq * 4); }
#pragma unroll
      EPI_ROWS rr[ai][m] = __builtin_amdgcn_rsqf(fq_sum((p[ai][m][0] + p[ai][m][1]) + (p[ai][m][2] + p[ai][m][3])) * (1.0f / QL) + EPS); }
#pragma unroll
    EPI_ROWS { const int row = u.pm * 256 + ai * 128 + m * 16 + rl0; const int pos = row & (SEQ - 1); const float r = rr[ai][m];
#pragma unroll
        for (int bj = 0; bj < 2; ++bj) { const int c = u.pn * 256 + bj * 128 + cl0; const int e = c % DQK;
            f32x4 v0 = acc[ai][bj][m][0] * r, v1 = acc[ai][bj][m][1] * r;
            if (e >= DN) { f32x4 cs4, sn4; rope_cs(pos, (e - DN) >> 1, cs4, sn4); rope8(v0, v1, cs4, sn4); }
            *(u32x4*)(Q + (size_t)row * 768 + c) = pack8(v0, v1); } }
}
__device__ __forceinline__ void epi_kv(EPI_ARGS) {
    const int rl0 = wr * 64 + fr, cl0 = wc * 32 + 8 * fq;
    const float* PS1 = (const float*)((unsigned char*)E.out + DO_PS1); bf16_t* Kf = (bf16_t*)(E.ws + WS_KF); bf16_t* V = (bf16_t*)(E.ws + WS_V);
    float rr[2][4];
    { f32x4 p[2][4];
#pragma unroll
      EPI_ROWS { p[ai][m] = (f32x4){0.f, 0.f, 0.f, 0.f}; if (fq < 2) p[ai][m] = *(const f32x4*)(PS1 + (size_t)(u.pm * 256 + ai * 128 + m * 16 + rl0) * 24 + 12 + fq * 4); }
#pragma unroll
      EPI_ROWS rr[ai][m] = __builtin_amdgcn_rsqf(fq_sum((p[ai][m][0] + p[ai][m][1]) + (p[ai][m][2] + p[ai][m][3])) * (1.0f / KVL) + EPS); }
#pragma unroll
    EPI_ROWS { const int row = u.pm * 256 + ai * 128 + m * 16 + rl0; const float r = rr[ai][m];
#pragma unroll
        for (int bj = 0; bj < 2; ++bj) { const int c = u.pn * 256 + bj * 128 + cl0; const int h = c >> 7, e = c & 127;
            const u32x4 w = pack8(acc[ai][bj][m][0] * r, acc[ai][bj][m][1] * r);
            if (e < DN) *(u32x4*)(Kf + (size_t)row * 768 + h * DQK + e) = w; else *(u32x4*)(V + (size_t)row * 512 + h * DVH + (e - DN)) = w; } }
}
template <int OMIB> __device__ __forceinline__ void epi_plain(EPI_ARGS, int rowbase, int colbase) {
    const int rl0 = wr * 64 + fr, cl0 = wc * 32 + 8 * fq;
    bf16_t* O = (bf16_t*)(E.ws + (size_t)OMIB * MiB);
#pragma unroll
    EPI_ROWS { const int row = rowbase + ai * 128 + m * 16 + rl0;
#pragma unroll
        for (int bj = 0; bj < 2; ++bj) *(u32x4*)(O + (size_t)row * 1024 + colbase + bj * 128 + cl0) = pack8(acc[ai][bj][m][0], acc[ai][bj][m][1]); }
}
__device__ __forceinline__ void epi_dft(EPI_ARGS) {
    const int rl0 = wr * 64 + fr, cl0 = wc * 32 + 8 * fq; const int bb = u.ty >> 1, eo = u.ty & 1;
    bf16_t* Y = (bf16_t*)(E.ws + WS_R0); const float* QD = (const float*)(E.ws + WS_EQDQ) + (size_t)(eo * 24 + bb) * 512 + u.pn * 256 + cl0;
    const float sg = ((fr & 1) ? -1.0f : 1.0f) * (eo ? -1.0f : 1.0f) * (1.0f / 512.0f);
    f32x4 lv[2][2];
#pragma unroll
    for (int bj = 0; bj < 2; ++bj) { lv[bj][0] = *(const f32x4*)(QD + bj * 128) * sg; lv[bj][1] = *(const f32x4*)(QD + bj * 128 + 4) * sg; }
#pragma unroll
    EPI_ROWS { const int r = u.pm * 256 + ai * 128 + m * 16 + rl0; const size_t row = (size_t)bb * SEQ + 2 * r + eo;
#pragma unroll
        for (int bj = 0; bj < 2; ++bj) *(u32x4*)(Y + row * 1024 + 512 + u.pn * 256 + bj * 128 + cl0) = pack8(acc[ai][bj][m][0] + lv[bj][0], acc[ai][bj][m][1] + lv[bj][1]); }
}
__device__ __forceinline__ void unpack8(const u32x4 w, f32x4& y0, f32x4& y1) {
    y0 = (f32x4){__uint_as_float(w.x << 16), __uint_as_float(w.x & 0xffff0000u), __uint_as_float(w.y << 16), __uint_as_float(w.y & 0xffff0000u)};
    y1 = (f32x4){__uint_as_float(w.z << 16), __uint_as_float(w.z & 0xffff0000u), __uint_as_float(w.w << 16), __uint_as_float(w.w & 0xffff0000u)};
}
template <int EKIND, int OMIB> __device__ __forceinline__ void epi_res(EPI_ARGS) {
    const int rl0 = wr * 64 + fr, cl0 = wc * 32 + 8 * fq;
    bf16_t* XB = (bf16_t*)(E.ws + WS_R1); float* PS = (float*)(E.ws + WS_PS);
    if constexpr (EKIND == EK_RES_X) {
#pragma unroll
        for (int ai = 0; ai < 2; ++ai) {
            f32x4 rs[4][2][2];
#pragma unroll
            for (int m = 0; m < 4; ++m) { const int row = u.pm * 256 + ai * 128 + m * 16 + rl0; const float* xr = (row < TP ? E.xp + (size_t)row * DM : E.xs + (size_t)(row - TP) * DM) + u.pn * 256 + cl0;
#pragma unroll
                for (int bj = 0; bj < 2; ++bj) { rs[m][bj][0] = *(const f32x4*)(xr + bj * 128); rs[m][bj][1] = *(const f32x4*)(xr + bj * 128 + 4); } }
#pragma unroll
            for (int m = 0; m < 4; ++m) { const int row = u.pm * 256 + ai * 128 + m * 16 + rl0; float ss = 0.f;
#pragma unroll
                for (int bj = 0; bj < 2; ++bj) { const f32x4 y0 = rs[m][bj][0] + acc[ai][bj][m][0], y1 = rs[m][bj][1] + acc[ai][bj][m][1];
                    *(u32x4*)(XB + (size_t)row * DM + u.pn * 256 + bj * 128 + cl0) = pack8(y0, y1); ss += sumsq8(y0, y1); }
                ss = fq_sum(ss); if (fq == 0) PS[(size_t)row * 16 + u.pn * 4 + wc] = ss; }
        }
    } else {
        u32x4 rs[2][4][2];
#pragma unroll
        EPI_ROWS { const int row = u.pm * 256 + ai * 128 + m * 16 + rl0;
#pragma unroll
            for (int bj = 0; bj < 2; ++bj) rs[ai][m][bj] = *(const u32x4*)(XB + (size_t)row * DM + u.pn * 256 + bj * 128 + cl0); }
#pragma unroll
        EPI_ROWS { const int row = u.pm * 256 + ai * 128 + m * 16 + rl0; float ss = 0.f;
#pragma unroll
            for (int bj = 0; bj < 2; ++bj) { f32x4 y0, y1; unpack8(rs[ai][m][bj], y0, y1); y0 += acc[ai][bj][m][0]; y1 += acc[ai][bj][m][1];
                *(u32x4*)(XB + (size_t)row * DM + u.pn * 256 + bj * 128 + cl0) = pack8(y0, y1); ss += sumsq8(y0, y1); }
            ss = fq_sum(ss); if (fq == 0) PS[(size_t)row * 16 + u.pn * 4 + wc] = ss; }
    }
}
template <int OMIB> __device__ __forceinline__ void epi_rowscale(EPI_ARGS) {
    const int rl0 = wr * 64 + fr, cl0 = wc * 32 + 8 * fq;
    bf16_t* O = (bf16_t*)(E.ws + (size_t)OMIB * MiB); const float* PS = (const float*)(E.ws + WS_PS);
    float rr[2][4]; rows_r16(PS, u.pm * 256 + rl0, fq, rr);
#pragma unroll
    EPI_ROWS { const int row = u.pm * 256 + ai * 128 + m * 16 + rl0; const float r = rr[ai][m];
#pragma unroll
        for (int bj = 0; bj < 2; ++bj) *(u32x4*)(O + (size_t)row * 1024 + u.pn * 256 + bj * 128 + cl0) = pack8(acc[ai][bj][m][0] * r, acc[ai][bj][m][1] * r); }
}
template <int OMIB, bool ST> __device__ __forceinline__ void epi_swiglu(EPI_ARGS) {
    const int rl0 = wr * 64 + fr, cl0 = wc * 32 + 8 * fq;
    bf16_t* O = (bf16_t*)(E.ws + (size_t)OMIB * MiB); const float* PS = (const float*)(E.ws + WS_PS);
    float rr[2][4]; rows_r16(PS, u.pm * 256 + rl0, fq, rr);
#pragma unroll
    EPI_ROWS { const int row = u.pm * 256 + ai * 128 + m * 16 + rl0; const float r = rr[ai][m];
        f32x4 h[2];
#pragma unroll
        for (int n = 0; n < 2; ++n)
#pragma unroll
            for (int e = 0; e < 4; ++e) { const float g = acc[ai][0][m][n][e] * r, up = acc[ai][1][m][n][e] * r;
                h[n][e] = g * __builtin_amdgcn_rcpf(1.0f + __builtin_amdgcn_exp2f(-g * LOG2E)) * up; }
        const u32x4 pk = pack8(h[0], h[1]); if (ST) *(u32x4*)(O + (size_t)row * DFF + u.pn * 128 + cl0) = pk; else asm volatile("" :: "v"(pk)); }
}
template <int OMIB> __device__ __forceinline__ void epi_softmax(EPI_ARGS) {
    const int rl0 = wr * 64 + fr, cl0 = wc * 32 + 8 * fq;
    bf16_t* O = (bf16_t*)(E.ws + (size_t)OMIB * MiB);
    LAS f32x2* TB = (LAS f32x2*)(lds + LDS_SMX);
    float mloc[2][4];
#pragma unroll
    EPI_ROWS {
        float mx = -3.0e38f;
#pragma unroll
        for (int bj = 0; bj < 2; ++bj)
#pragma unroll
            for (int n = 0; n < 2; ++n)
#pragma unroll
                for (int e = 0; e < 4; ++e) mx = fmaxf(mx, acc[ai][bj][m][n][e]);
        mx = fq_max(mx); float s = 0.f;
#pragma unroll
        for (int bj = 0; bj < 2; ++bj)
#pragma unroll
            for (int n = 0; n < 2; ++n)
#pragma unroll
                for (int e = 0; e < 4; ++e) { const float p = __builtin_amdgcn_exp2f(acc[ai][bj][m][n][e] - mx); acc[ai][bj][m][n][e] = p; s += p; }
        s = fq_sum(s); mloc[ai][m] = mx;
        if (fq == 0) TB[(ai * 128 + m * 16 + rl0) * 4 + wc] = (f32x2){mx, s};
    }
    LDS_WAIT(); __builtin_amdgcn_s_barrier(); asm volatile("" ::: "memory");
#pragma unroll
    EPI_ROWS { const int rl = ai * 128 + m * 16 + rl0; const int row = u.pm * 256 + rl;
        const f32x2 t0 = TB[rl * 4 + 0], t1 = TB[rl * 4 + 1], t2 = TB[rl * 4 + 2], t3 = TB[rl * 4 + 3];
        const float M = fmaxf(fmaxf(t0.x, t1.x), fmaxf(t2.x, t3.x));
        const float L = t0.y * __builtin_amdgcn_exp2f(t0.x - M) + t1.y * __builtin_amdgcn_exp2f(t1.x - M) + t2.y * __builtin_amdgcn_exp2f(t2.x - M) + t3.y * __builtin_amdgcn_exp2f(t3.x - M);
        const float f = __builtin_amdgcn_exp2f(mloc[ai][m] - M) * __builtin_amdgcn_rcpf(L);
#pragma unroll
        for (int bj = 0; bj < 2; ++bj) *(u32x4*)(O + (size_t)row * 1024 + u.pn * 256 + bj * 128 + cl0) = pack8(acc[ai][bj][m][0] * f, acc[ai][bj][m][1] * f); }
    LDS_WAIT(); __builtin_amdgcn_s_barrier(); asm volatile("" ::: "memory");
}
template <int EKIND, int OMIB> __device__ __forceinline__ void epilogue(EPI_ARGS) {
    if constexpr (EKIND == EK_P1) epi_p1(E, acc, u, wr, wc, fr, fq, lds);
    else if constexpr (EKIND == EK_Q) epi_q(E, acc, u, wr, wc, fr, fq, lds);
    else if constexpr (EKIND == EK_KV) epi_kv(E, acc, u, wr, wc, fr, fq, lds);
    else if constexpr (EKIND == EK_DFT) epi_dft(E, acc, u, wr, wc, fr, fq, lds);
    else if constexpr (EKIND == EK_RES || EKIND == EK_RES_X || EKIND == EK_RES_NOB) epi_res<EKIND, OMIB>(E, acc, u, wr, wc, fr, fq, lds);
    else if constexpr (EKIND == EK_ROWSCALE) epi_rowscale<OMIB>(E, acc, u, wr, wc, fr, fq, lds);
    else if constexpr (EKIND == EK_PLAIN) epi_plain<OMIB>(E, acc, u, wr, wc, fr, fq, lds, u.pm * 256, u.pn * 256);
    else if constexpr (EKIND == EK_SWIGLU) epi_swiglu<OMIB, true>(E, acc, u, wr, wc, fr, fq, lds);
    else if constexpr (EKIND == EK_SWIGLU_NOST) epi_swiglu<OMIB, false>(E, acc, u, wr, wc, fr, fq, lds);
    else if constexpr (EKIND == EK_NONE) {
#pragma unroll
        for (int ai = 0; ai < 2; ++ai)
#pragma unroll
            for (int bj = 0; bj < 2; ++bj)
#pragma unroll
                for (int m = 0; m < 4; ++m)
#pragma unroll
                    for (int n = 0; n < 2; ++n) asm volatile("" :: "v"(acc[ai][bj][m][n]));
    }
    else epi_softmax<OMIB>(E, acc, u, wr, wc, fr, fq, lds);
}

template <int SKIND, int NN, int LDA, int LDB, int K, int EKIND, int OMIB>
__device__ __forceinline__ void gemm_phase(LAS unsigned char* lds, const Sched<SKIND, NN, LDA, LDB>& S, const Epi& E) {
    constexpr int lda = LDA, ldb = LDB;
    using namespace pg8;
    const int tid = threadIdx.x, wid = __builtin_amdgcn_readfirstlane(tid >> 6), lane = tid & 63, wr = wid >> 2, wc = wid & 3, fr = lane & 15, fq = lane >> 4;
    const int nt = K / BK;
    unsigned voffA[2], voffB[2];
#pragma unroll
    for (int i = 0; i < 2; ++i) { int R, C; stage_rc(tid * 16 + i * 8192, R, C); const int Rb = (R & ~31) + perm32(R & 31);
        voffA[i] = (unsigned)(R * lda + C) * 2u; voffB[i] = (unsigned)(Rb * ldb + C) * 2u; }
    const size_t kstep = (size_t)(BK * 2);
    const size_t hstepA = (size_t)HALF * lda * 2, hstepB = (size_t)HALF * ldb * 2;
    const unsigned ldsw = (unsigned)wid * 1024u;
    const int aoff = lds_byte(wr * 64 + fr, fq * 8), boff = lds_byte(wc * 32 + fr, fq * 8);
#define PG8_SA(b, h) (((b) * 2 + (h)) * HTB)
#define PG8_SB(b, h) ((4 + (b) * 2 + (h)) * HTB)
#define PG8_STAGE(bufoff, gbase, voff) do { _Pragma("unroll") for (int _i = 0; _i < 2; ++_i) \
        __builtin_amdgcn_global_load_lds((const unsigned*)((const char*)(gbase) + (voff)[_i]), (LAS unsigned*)(lds + (bufoff) + ldsw + _i * 8192), 16, 0, 0); } while (0)
#define PG8_LDA(dst, b, h) do { _Pragma("unroll") for (int m = 0; m < 4; ++m) _Pragma("unroll") for (int k = 0; k < 2; ++k) dst[m][k] = *(const LAS bf16x8*)(lds + PG8_SA(b, h) + aoff + m * 2048 + k * 1024); } while (0)
#define PG8_LDB(dst, b, h) do { _Pragma("unroll") for (int n = 0; n < 2; ++n) _Pragma("unroll") for (int k = 0; k < 2; ++k) dst[n][k] = *(const LAS bf16x8*)(lds + PG8_SB(b, h) + boff + n * 2048 + k * 1024); } while (0)
#define PG8_MMA(ai, bj, At, Bt) do { __builtin_amdgcn_s_setprio(1); _Pragma("unroll") for (int m = 0; m < 4; ++m) _Pragma("unroll") for (int n = 0; n < 2; ++n) _Pragma("unroll") for (int k = 0; k < 2; ++k) \
        acc[ai][bj][m][n] = __builtin_amdgcn_mfma_f32_16x16x32_bf16(Bt[n][k], At[m][k], acc[ai][bj][m][n], 0, 0, 0); __builtin_amdgcn_s_setprio(0); } while (0)
#define PG8_WAIT_V(n) asm volatile("s_waitcnt vmcnt(" #n ")" ::: "memory")
#define PG8_WAIT_L(n) asm volatile("s_waitcnt lgkmcnt(" #n ")" ::: "memory")
#define PG8_BAR __builtin_amdgcn_s_barrier()
#define PG8_SCHED __builtin_amdgcn_sched_barrier(0)
    Unit cur, nxt; int ui = 0;
    if (!S.next(0, cur)) return;
    f32x4 acc[2][2][4][2];
#pragma unroll
    for (int a = 0; a < 2; ++a)
#pragma unroll
        for (int b = 0; b < 2; ++b)
#pragma unroll
            for (int m = 0; m < 4; ++m)
#pragma unroll
                for (int n = 0; n < 2; ++n) acc[a][b][m][n] = (f32x4){0.f, 0.f, 0.f, 0.f};
    bf16x8 At[4][2], B0[2][2], B1[2][2];
    const char* cA = cur.a; const char* cB = cur.b;
    PG8_STAGE(PG8_SB(0, 0), cB, voffB); PG8_STAGE(PG8_SB(0, 1), cB + hstepB, voffB); PG8_STAGE(PG8_SA(0, 0), cA, voffA); PG8_STAGE(PG8_SA(0, 1), cA + hstepA, voffA);
    if (wr == 1) PG8_BAR;
    PG8_WAIT_V(2); PG8_BAR;
    PG8_STAGE(PG8_SB(1, 0), cB + kstep, voffB); PG8_STAGE(PG8_SA(1, 0), cA + kstep, voffA); PG8_STAGE(PG8_SB(1, 1), cB + hstepB + kstep, voffB);
    PG8_WAIT_V(6); PG8_BAR;
    for (;;) {
        const bool has_next = S.next(ui + 1, nxt);
        const char* nA = has_next ? nxt.a : cA; const char* nB = has_next ? nxt.b : cB;
#pragma unroll 1
        for (int t = 0; t < nt; t += 2) {
            const bool last = (t == nt - 2);
            const char* a1 = cA + (size_t)(t + 1) * kstep;
            const char* a2 = last ? nA : cA + (size_t)(t + 2) * kstep; const char* b2 = last ? nB : cB + (size_t)(t + 2) * kstep;
            const char* a3 = a2 + kstep; const char* b3 = b2 + kstep;
            PG8_LDB(B0, 0, 0); PG8_LDB(B1, 0, 1); PG8_SCHED; PG8_LDA(At, 0, 0); PG8_STAGE(PG8_SA(1, 1), a1 + hstepA, voffA);
            PG8_WAIT_V(8); PG8_WAIT_L(0); PG8_BAR; PG8_MMA(0, 0, At, B0); PG8_MMA(0, 1, At, B1); PG8_BAR; PG8_SCHED;
            PG8_LDA(At, 0, 1); PG8_STAGE(PG8_SB(0, 0), b2, voffB); PG8_STAGE(PG8_SB(0, 1), b2 + hstepB, voffB); PG8_STAGE(PG8_SA(0, 0), a2, voffA);
            PG8_WAIT_V(8); PG8_WAIT_L(0); PG8_BAR; PG8_MMA(1, 0, At, B0); PG8_MMA(1, 1, At, B1); PG8_BAR; PG8_SCHED;
            PG8_LDB(B0, 1, 0); PG8_LDB(B1, 1, 1); PG8_SCHED; PG8_LDA(At, 1, 0); PG8_STAGE(PG8_SA(0, 1), a2 + hstepA, voffA);
            PG8_WAIT_V(8); PG8_WAIT_L(0); PG8_BAR; PG8_MMA(0, 0, At, B0); PG8_MMA(0, 1, At, B1); PG8_BAR; PG8_SCHED;
            PG8_LDA(At, 1, 1); PG8_STAGE(PG8_SB(1, 0), b3, voffB); PG8_STAGE(PG8_SB(1, 1), b3 + hstepB, voffB); PG8_STAGE(PG8_SA(1, 0), a3, voffA);
            PG8_WAIT_V(8); PG8_WAIT_L(0); PG8_BAR; PG8_MMA(1, 0, At, B0); PG8_MMA(1, 1, At, B1); PG8_BAR; PG8_SCHED;
        }
        if (wr == 0) PG8_BAR;
        epilogue<EKIND, OMIB>(E, acc, cur, wr, wc, fr, fq, lds);
        if (!has_next) break;
#pragma unroll
        for (int a = 0; a < 2; ++a)
#pragma unroll
            for (int b = 0; b < 2; ++b)
#pragma unroll
                for (int m = 0; m < 4; ++m)
#pragma unroll
                    for (int n = 0; n < 2; ++n) acc[a][b][m][n] = (f32x4){0.f, 0.f, 0.f, 0.f};
        cur = nxt; cA = nA; cB = nB; ++ui;
        if (wr == 1) PG8_BAR;
    }
    PG8_WAIT_V(0);
    PG8_BAR;
#undef PG8_SA
#undef PG8_SB
#undef PG8_STAGE
#undef PG8_LDA
#undef PG8_LDB
#undef PG8_MMA
#undef PG8_WAIT_V
#undef PG8_WAIT_L
#undef PG8_BAR
#undef PG8_SCHED
}

namespace mla {
constexpr int NW = 8, QBLK = 32, KVBLK = 64, NT = SEQ / KVBLK;
constexpr int KSLOT = 12288, VSLOT = 8192;
constexpr int LDS_K = 0, LDS_V = 3 * KSLOT, LDS_WS = LDS_V + 3 * VSLOT, LDS_OST = LDS_WS + NW * 256, BYTES = LDS_OST + NW * 4096;
constexpr int LDQ = 768, LDK = 768, LDV = 512, LDO = 1024;
#define ATT_THR 8.0f
#define SBAR() __builtin_amdgcn_sched_barrier(0)
#define PIN(x) asm volatile("" : "+v"(x))
#define MFMA(a, b, c) __builtin_amdgcn_mfma_f32_32x32x16_bf16(a, b, c, 0, 0, 0)
#define WAIT_BAR(N) asm volatile("s_waitcnt vmcnt(" #N ") lgkmcnt(0)\n\ts_barrier" ::: "memory")
#define WB(NLO, NHI) do { if (w4) { WAIT_BAR(NHI); } else { WAIT_BAR(NLO); } } while (0)
__device__ __forceinline__ int crow(int r, int hi) { return (r & 3) + 8 * (r >> 2) + 4 * hi; }
__device__ __forceinline__ unsigned cvtpk(float lo, float hi) { unsigned r; asm("v_cvt_pk_bf16_f32 %0, %1, %2" : "=v"(r) : "v"(lo), "v"(hi)); return r; }
__device__ __forceinline__ void glds16(const void* g, unsigned lds_base) {
    unsigned sv; asm volatile("s_mov_b32 %0, m0\n\ts_mov_b32 m0, %2\n\ts_nop 0\n\tglobal_load_lds_dwordx4 %1, off\n\ts_mov_b32 m0, %0" : "=&s"(sv) : "v"(g), "s"(lds_base) : "memory"); }
typedef __attribute__((address_space(3))) const char* lds_cptr;
typedef short v4i16_t __attribute__((ext_vector_type(4)));
__device__ __forceinline__ void kload2(bf16x8* kf, lds_cptr kp, int d0) { kf[2 * d0] = *(const __attribute__((address_space(3))) bf16x8*)(kp + d0 * 2048); kf[2 * d0 + 1] = *(const __attribute__((address_space(3))) bf16x8*)(kp + d0 * 2048 + 512); }
__device__ __forceinline__ s16x4 vtr(lds_cptr p) { return __builtin_bit_cast(s16x4, __builtin_amdgcn_ds_read_tr16_b64_v4i16((__attribute__((address_space(3))) v4i16_t*)p)); }
#define MX3(a, b, c) __builtin_fmaxf(__builtin_fmaxf((a), (b)), (c))
__device__ __forceinline__ float rowmax(const f32x16& p0, const f32x16& p1) {
    float a = MX3(p0[0], p0[1], p1[0]), b = MX3(p0[2], p0[3], p1[1]); a = MX3(a, p1[2], p1[3]);
#pragma unroll
    for (int r = 4; r < 16; r += 4) { a = MX3(a, p0[r], p0[r + 1]); b = MX3(b, p0[r + 2], p0[r + 3]); a = MX3(a, p1[r], p1[r + 1]); b = MX3(b, p1[r + 2], p1[r + 3]); }
    float m = __builtin_fmaxf(a, b); auto rr = __builtin_amdgcn_permlane32_swap(__float_as_uint(m), __float_as_uint(m), false, false);
    return __builtin_fmaxf(__uint_as_float(rr[0]), __uint_as_float(rr[1])); }

__device__ __forceinline__ void attn_unit(const bf16_t* __restrict__ Qb, const bf16_t* __restrict__ Kh, const bf16_t* __restrict__ Vh, bf16_t* __restrict__ Ob, char* lds) {
    const int tid = threadIdx.x, lane = tid & 63, r32 = lane & 31, hi = lane >> 5; const int wid = __builtin_amdgcn_readfirstlane(tid >> 6); const bool w4 = wid < 4;
    const bf16_t* Qw = Qb + (size_t)(wid * QBLK) * LDQ;
    const unsigned lds0 = (unsigned)(uintptr_t)lds; float* wsf = (float*)(lds + LDS_WS) + wid * 64;
    const bf16_t* ksrc = Kh + (size_t)lane * LDK + wid * 8;
    const bf16_t* vsrc = Vh + (size_t)(16 * (wid & 3) + (lane >> 2)) * LDV + (wid >> 2) * 32 + (lane & 3) * 8;
    const unsigned kdst = lds0 + LDS_K + wid * 1024, vdst = lds0 + LDS_V + wid * 1024;
#define DMA_K(t, slot) do { glds16(ksrc + (size_t)(t) * KVBLK * LDK, (unsigned)__builtin_amdgcn_readfirstlane(kdst + (slot))); \
        if (w4) glds16(ksrc + (size_t)(t) * KVBLK * LDK + 64, (unsigned)__builtin_amdgcn_readfirstlane(kdst + 8192 + (slot))); } while (0)
#define DMA_V(t, slot) glds16(vsrc + (size_t)(t) * KVBLK * LDV, (unsigned)__builtin_amdgcn_readfirstlane(vdst + (slot)))
    const lds_cptr vp0 = (lds_cptr)lds + LDS_V + ((lane >> 4) & 1) * 32 + (lane & 3) * 8 + (4 * hi + ((lane & 15) >> 2)) * 64;
    const lds_cptr kp0 = (lds_cptr)lds + LDS_K + hi * 1024 + r32 * 16;
    DMA_K(0, 0); DMA_V(0, 0); DMA_K(1, KSLOT);
    bf16x8 qr[6];
#pragma unroll
    for (int d0 = 0; d0 < 6; ++d0) qr[d0] = *reinterpret_cast<const bf16x8*>(&Qw[(size_t)r32 * LDQ + d0 * 16 + hi * 8]);
    float mhat = 0.f, l_reg = 0.f; f32x16 o[2]; o[0] = f32x16{}; o[1] = f32x16{};
    const f32x16 zero16 = f32x16{};
    bool resc = false;
    f32x16 pA0, pA1, pB0, pB1; bf16x8 kf[12]; s16x4 vlo[8], vhi[8]; u32x4 pw0, pw1, pw2, pw3;
    int kl_cur = 0, kl_next = KSLOT, vl_prev = 0, vl_cur = 0, vl_next = VSLOT;
#define ROT() do { kl_cur = kl_next; kl_next = (kl_next == 2 * KSLOT) ? 0 : kl_next + KSLOT; vl_prev = vl_cur; vl_cur = vl_next; vl_next = (vl_next == 2 * VSLOT) ? 0 : vl_next + VSLOT; } while (0)
#define EX(v) __builtin_amdgcn_exp2f((v) + nmh)
#define RESC() do { if (resc) { _Pragma("unroll") for (int d_ = 0; d_ < 2; ++d_) _Pragma("unroll") for (int r = 0; r < 16; ++r) o[d_][r] *= wsf[crow(r, hi)]; } } while (0)
    DMA_K(2, 2 * KSLOT);
    WAIT_BAR(3);
    _Pragma("unroll") for (int d0 = 0; d0 < 6; ++d0) kload2(kf, kp0, d0);
    pA0 = MFMA(kf[0], qr[0], zero16); pA1 = MFMA(kf[1], qr[0], zero16);
#pragma unroll
    for (int d0 = 1; d0 < 6; ++d0) { pA0 = MFMA(kf[2 * d0], qr[d0], pA0); pA1 = MFMA(kf[2 * d0 + 1], qr[d0], pA1); }
    { const float rm = rowmax(pA0, pA1); mhat = rm; const float nmh = -mhat;
#pragma unroll
      for (int r = 0; r < 16; ++r) { pA0[r] = EX(pA0[r]); pA1[r] = EX(pA1[r]); } }
    WAIT_BAR(0);
    DMA_K(3, 0); DMA_V(1, VSLOT); ROT();
    _Pragma("unroll") for (int d0 = 0; d0 < 6; ++d0) kload2(kf, kp0 + kl_cur, d0);
    WB(2, 3);
#define PKW(P, i) cvtpk(P[i], P[i + 1])
#define PAF(k) __builtin_bit_cast(bf16x8, pw##k)
#define VFR(i) (bf16x8){vlo[i][0], vlo[i][1], vlo[i][2], vlo[i][3], vhi[i][0], vhi[i][1], vhi[i][2], vhi[i][3]}
#define VRD(i) do { vlo[i] = vtr(vp_ + (((i) >> 2) * 4096 + ((i) & 3) * 1024)); vhi[i] = vtr(vp_ + (((i) >> 2) * 4096 + ((i) & 3) * 1024 + 512)); } while (0)
#define KRD(G, d0) do { if (G) { kload2(kf, kp0 + kl_next, d0); SBAR(); } } while (0)
#define GAPA3(MF, a0, a1, a2, W0, W1, PW) do { MF; sacc += a0; sacc += a1; sacc += a2; W0; W1; PIN(PW); PIN(sacc); SBAR(); } while (0)
#define GAPA2(MF, a0, a1) do { MF; sacc += a0; sacc += a1; PIN(sacc); SBAR(); } while (0)
#define GAPB(MF, X, i) do { MF; X[i] = EX(X[i]); X[i + 1] = EX(X[i + 1]); X[i + 2] = EX(X[i + 2]); X[i + 3] = EX(X[i + 3]); PIN(X); SBAR(); } while (0)
#define STEP(C0, C1, P0, P1, t, GK, GV, GL) do { SBAR(); \
    const lds_cptr vp_ = vp0 + vl_prev; \
    VRD(0); SBAR(); float sacc = P0[0] + P0[1]; \
                    GAPA3(C0 = MFMA(kf[0], qr[0], zero16), P0[2], P0[3], P0[4],    pw0[0] = PKW(P0, 0),  pw0[1] = PKW(P0, 2),  pw0); \
    VRD(4); SBAR(); GAPA3(C1 = MFMA(kf[1], qr[0], zero16), P0[5], P0[6], P0[7],    pw0[2] = PKW(P0, 4),  pw0[3] = PKW(P0, 6),  pw0); \
    VRD(1); SBAR(); GAPA3(C0 = MFMA(kf[2], qr[1], C0),    P0[8], P0[9], P0[10],   pw1[0] = PKW(P0, 8),  pw1[1] = PKW(P0, 10), pw1); \
    VRD(5); SBAR(); GAPA3(C1 = MFMA(kf[3], qr[1], C1),    P0[11], P0[12], P0[13], pw1[2] = PKW(P0, 12), pw1[3] = PKW(P0, 14), pw1); \
    VRD(2); SBAR(); GAPA3(C0 = MFMA(kf[4], qr[2], C0),    P0[14], P0[15], P1[0],  pw2[0] = PKW(P1, 0),  pw2[1] = PKW(P1, 2),  pw2); \
    VRD(6); SBAR(); GAPA3(C1 = MFMA(kf[5], qr[2], C1),    P1[1], P1[2], P1[3],    pw2[2] = PKW(P1, 4),  pw2[3] = PKW(P1, 6),  pw2); \
    VRD(3); SBAR(); GAPA3(C0 = MFMA(kf[6], qr[3], C0),    P1[4], P1[5], P1[6],    pw3[0] = PKW(P1, 8),  pw3[1] = PKW(P1, 10), pw3); \
    VRD(7); SBAR(); GAPA3(C1 = MFMA(kf[7], qr[3], C1),    P1[7], P1[8], P1[9],    pw3[2] = PKW(P1, 12), pw3[3] = PKW(P1, 14), pw3); \
    GAPA2(C0 = MFMA(kf[8], qr[4], C0), P1[10], P1[11]); \
    GAPA2(C1 = MFMA(kf[9], qr[4], C1), P1[12], P1[13]); \
    GAPA2(C0 = MFMA(kf[10], qr[5], C0), P1[14], P1[15]); \
    C1 = MFMA(kf[11], qr[5], C1); SBAR(); \
    l_reg += sacc; \
    if (GK) DMA_K((t) + 3, kl_cur); if (GV) DMA_V((t) + 1, vl_next); \
    { const float rm = rowmax(C0, C1) - mhat; resc = false; \
      if (__builtin_expect(__any(rm > ATT_THR), 0)) { const float dl = __builtin_fmaxf(rm, 0.f); mhat += dl; \
          const float f = __builtin_amdgcn_exp2f(-dl); l_reg *= f; if (hi == 0) wsf[r32] = f; resc = true; } } \
    const float nmh = -mhat; SBAR(); \
    GAPB(o[0] = MFMA(PAF(0), VFR(0), o[0]), C0, 0); \
    KRD(GL, 0); GAPB(o[1] = MFMA(PAF(0), VFR(4), o[1]), C0, 4); \
    KRD(GL, 1); GAPB(o[0] = MFMA(PAF(1), VFR(1), o[0]), C0, 8); \
    KRD(GL, 2); GAPB(o[1] = MFMA(PAF(1), VFR(5), o[1]), C0, 12); \
    KRD(GL, 3); GAPB(o[0] = MFMA(PAF(2), VFR(2), o[0]), C1, 0); \
    KRD(GL, 4); GAPB(o[1] = MFMA(PAF(2), VFR(6), o[1]), C1, 4); \
    KRD(GL, 5); GAPB(o[0] = MFMA(PAF(3), VFR(3), o[0]), C1, 8); \
    GAPB(o[1] = MFMA(PAF(3), VFR(7), o[1]), C1, 12); \
    } while (0)
    int t = 1;
    for (; t + 5 < NT; t += 2) {
        STEP(pB0, pB1, pA0, pA1, t, true, true, true);     WB(2, 3); RESC(); ROT();
        STEP(pA0, pA1, pB0, pB1, t + 1, true, true, true); WB(2, 3); RESC(); ROT();
    }
#define ENDW(tt) do { if ((tt) + 3 < NT) { WB(2, 3); } else if ((tt) + 2 < NT) { WAIT_BAR(1); } else { WAIT_BAR(0); } } while (0)
    for (; t + 1 < NT; t += 2) {
        STEP(pB0, pB1, pA0, pA1, t, (t + 3 < NT), (t + 1 < NT), (t + 1 < NT));         ENDW(t);     RESC(); ROT();
        STEP(pA0, pA1, pB0, pB1, t + 1, (t + 4 < NT), (t + 2 < NT), (t + 2 < NT));     ENDW(t + 1); RESC(); ROT();
    }
    STEP(pB0, pB1, pA0, pA1, NT - 1, false, false, false); RESC();
    { float sacc = pB0[0] + pB0[1];
#pragma unroll
      for (int r = 2; r < 16; ++r) sacc += pB0[r];
#pragma unroll
      for (int r = 0; r < 16; ++r) sacc += pB1[r];
      l_reg += sacc;
      pw0 = (u32x4){PKW(pB0, 0), PKW(pB0, 2), PKW(pB0, 4), PKW(pB0, 6)}; pw1 = (u32x4){PKW(pB0, 8), PKW(pB0, 10), PKW(pB0, 12), PKW(pB0, 14)};
      pw2 = (u32x4){PKW(pB1, 0), PKW(pB1, 2), PKW(pB1, 4), PKW(pB1, 6)}; pw3 = (u32x4){PKW(pB1, 8), PKW(pB1, 10), PKW(pB1, 12), PKW(pB1, 14)};
      const lds_cptr vp_ = vp0 + vl_cur; _Pragma("unroll") for (int i = 0; i < 8; ++i) VRD(i);
      o[0] = MFMA(PAF(0), VFR(0), o[0]); o[1] = MFMA(PAF(0), VFR(4), o[1]); o[0] = MFMA(PAF(1), VFR(1), o[0]); o[1] = MFMA(PAF(1), VFR(5), o[1]);
      o[0] = MFMA(PAF(2), VFR(2), o[0]); o[1] = MFMA(PAF(2), VFR(6), o[1]); o[0] = MFMA(PAF(3), VFR(3), o[0]); o[1] = MFMA(PAF(3), VFR(7), o[1]); }
    { auto rr = __builtin_amdgcn_permlane32_swap(__float_as_uint(l_reg), __float_as_uint(l_reg), false, false); l_reg = __uint_as_float(rr[0]) + __uint_as_float(rr[1]); }
    if (hi == 0) wsf[32 + r32] = l_reg; asm volatile("s_waitcnt lgkmcnt(0)" ::: "memory");
    float rli[16];
#pragma unroll
    for (int r = 0; r < 16; ++r) rli[r] = __builtin_amdgcn_rcpf(wsf[32 + crow(r, hi)]);
    bf16_t* Ow = Ob + (size_t)(wid * QBLK) * LDO; bf16_t* stg = (bf16_t*)(lds + LDS_OST) + wid * 2048;
#pragma unroll
    for (int r = 0; r < 16; ++r) { const int orow = crow(r, hi);
#pragma unroll
        for (int d0 = 0; d0 < 2; ++d0) stg[orow * 64 + d0 * 32 + r32] = (bf16_t)(cvtpk(o[d0][r] * rli[r], 0.f) & 0xffffu); }
    asm volatile("s_waitcnt lgkmcnt(0)" ::: "memory");
#pragma unroll
    for (int i = 0; i < 4; ++i) { const int row = i * 8 + (lane >> 3), ch = lane & 7; *(u32x4*)(Ow + (size_t)row * LDO + ch * 8) = *(const u32x4*)(stg + row * 64 + ch * 8); }
    asm volatile("s_waitcnt lgkmcnt(0)\n\ts_barrier" ::: "memory");
#undef DMA_K
#undef DMA_V
#undef ROT
#undef EX
#undef RESC
#undef PKW
#undef PAF
#undef VFR
#undef VRD
#undef KRD
#undef ENDW
#undef GAPA3
#undef GAPA2
#undef GAPB
#undef STEP
}
#undef SBAR
#undef PIN
#undef MFMA
#undef WAIT_BAR
#undef WB
#undef MX3
}

#define XB_TMO      128
#define XB_XCNT(j)  (256  + 64 * (j))
#define XB_XSUB(j)  (1280 + 64 * (j))
#define XB_XGEN(j)  (2304 + 64 * (j))
#define XB_TOP      3328
#define XB_TOPGEN   3392
#define XCD_BAR_WORDS 3456
#define XB_SPIN_CAP (1u << 18)
__device__ __forceinline__ unsigned xb_ld(unsigned* p)              { return __hip_atomic_load(p, __ATOMIC_RELAXED, __HIP_MEMORY_SCOPE_AGENT); }
__device__ __forceinline__ unsigned xb_add(unsigned* p, unsigned v) { return __hip_atomic_fetch_add(p, v, __ATOMIC_RELAXED, __HIP_MEMORY_SCOPE_AGENT); }
__device__ __forceinline__ unsigned xb_xcc_id() { return (unsigned)__builtin_amdgcn_s_getreg((3 << 11) | 20) & 0xFu; }
#define XB_SPIN(cond, bar) do { unsigned _sp = 0; while (cond) { __builtin_amdgcn_s_sleep(1); \
    if ((++_sp & 255u) == 0u) { if (xb_ld(&(bar)[XB_TMO])) break; if (_sp > XB_SPIN_CAP) { atomicAdd(&(bar)[XB_TMO], 1u); break; } } } } while (0)
struct XcdBarrier { unsigned* bar; unsigned x; volatile LAS unsigned* st; };
__device__ __forceinline__ XcdBarrier xcd_barrier_post(unsigned* bar, volatile LAS unsigned* st) {
    XcdBarrier b; b.bar = bar; b.x = xb_xcc_id(); b.st = st;
    if (threadIdx.x == 0) (void)xb_add(&bar[XB_XCNT(b.x)], 1u);
    return b;
}
__device__ __forceinline__ void xcd_barrier_complete(unsigned* bar, unsigned x, unsigned& nloc, unsigned& nx) {
    const unsigned G = gridDim.x * gridDim.y * gridDim.z;
    unsigned sum, cnt, mine, sp = 0u;
    for (;;) {
        sum = 0u; cnt = 0u; mine = 0u;
#pragma unroll
        for (unsigned j = 0; j < 16; ++j) { const unsigned c = xb_ld(&bar[XB_XCNT(j)]); sum += c; cnt += (c > 0u) ? 1u : 0u; mine = (j == x) ? c : mine; }
        if (sum == G) break;
        __builtin_amdgcn_s_sleep(1);
        if ((++sp & 255u) == 0u) { if (xb_ld(&bar[XB_TMO])) break; if (sp > XB_SPIN_CAP) { atomicAdd(&bar[XB_TMO], 1u); break; } }
    }
    nloc = mine > 0u ? mine : 1u; nx = cnt > 0u ? cnt : 1u;
}
__device__ __forceinline__ void xcd_barrier(const XcdBarrier& b) {
    asm volatile("s_waitcnt vmcnt(0)" ::: "memory");
    __syncthreads();
    if (threadIdx.x == 0) {
        unsigned* bar = b.bar;
        __builtin_amdgcn_s_waitcnt(0);
        unsigned nloc = b.st[0], nx = b.st[1];
        if (nloc == 0u) { xcd_barrier_complete(bar, b.x, nloc, nx); b.st[0] = nloc; b.st[1] = nx; }
        const unsigned old = xb_add(&bar[XB_XSUB(b.x)], 1u);
        const unsigned gen = old / nloc;
        if (old + 1u == (gen + 1u) * nloc) {
            __builtin_amdgcn_fence(__ATOMIC_RELEASE, "agent");
            asm volatile("s_waitcnt vmcnt(0)" ::: "memory");
            const unsigned og = xb_add(&bar[XB_TOP], 1u);
            const unsigned tg = og / nx;
            if (og + 1u == (tg + 1u) * nx) xb_add(&bar[XB_TOPGEN], 1u);
            else XB_SPIN(xb_ld(&bar[XB_TOPGEN]) == tg, bar);
            __builtin_amdgcn_fence(__ATOMIC_ACQUIRE, "agent");
            xb_add(&bar[XB_XGEN(b.x)], 1u);
            asm volatile("s_waitcnt vmcnt(0)" ::: "memory");
        } else {
            XB_SPIN(xb_ld(&bar[XB_XGEN(b.x)]) == gen, bar);
            __builtin_amdgcn_fence(__ATOMIC_ACQUIRE, "agent");
            asm volatile("s_waitcnt vmcnt(0)" ::: "memory");
        }
    }
    __syncthreads();
}

constexpr int NWAVES = 8;
constexpr int MISC_OFF = 139264 + 64;
constexpr int LDS_BYTES = 147456;
struct Frame { LAS unsigned char* lds; int tid, lane, wave, vcu, G; float* out; unsigned char* ws; };
struct Args { const float* in[21]; float* out; unsigned char* ws; int st_lo, st_hi; };

template <class F> __device__ __forceinline__ void transpose_item(const F& f, int item, int nblk, bf16_t* dst, int ldd, LAS float* scr, int lane) {
    const int kb = item / nblk, nb = item % nblk, k0 = 64 * kb, n0 = 32 * nb;
#pragma unroll 8
    for (int i = 0; i < 32; ++i) { const int kk = 2 * i + (lane >> 5); scr[kk * 33 + (lane & 31)] = f(k0 + kk, n0 + (lane & 31)); }
    LDS_WAIT(); asm volatile("" ::: "memory");
    const int c = lane & 7;
#pragma unroll
    for (int j = 0; j < 4; ++j) { const int n = (lane >> 3) + 8 * j; const LAS float* s = scr + (8 * c) * 33 + n;
        u32x4 o; o.x = cvt_pk_bf16(s[0 * 33], s[1 * 33]); o.y = cvt_pk_bf16(s[2 * 33], s[3 * 33]); o.z = cvt_pk_bf16(s[4 * 33], s[5 * 33]); o.w = cvt_pk_bf16(s[6 * 33], s[7 * 33]);
        *(u32x4*)(dst + (size_t)(n0 + n) * ldd + k0 + 8 * c) = o; }
    LDS_WAIT(); asm volatile("" ::: "memory");
}
__device__ __forceinline__ int rope_perm(int p) { return (p >> 1) + 16 * (p & 1); }
struct SrcWz { const float* w; __device__ __forceinline__ float operator()(int k, int n) const {
    if (n < 640) return w[(size_t)k * INW + n]; if (n < 672) return w[(size_t)k * INW + 640 + rope_perm(n - 640)]; return 0.f; } };
struct SrcPlain { const float* w; int ld, coff; __device__ __forceinline__ float operator()(int k, int n) const { return w[(size_t)k * ld + coff + n]; } };
struct SrcGain { const float* w; const float* g; int ld; float sc; __device__ __forceinline__ float operator()(int k, int n) const { return w[(size_t)k * ld + n] * g[k] * sc; } };
struct SrcUq { const float* w; const float* g; __device__ __forceinline__ float operator()(int k, int n) const {
    const int h = n / DQK, e = n % DQK; const int src = h * DQK + (e < DN ? e : DN + rope_perm(e - DN)); return w[(size_t)k * 768 + src] * g[k] * QSCALE; } };
struct SrcGu { const float* w; const float* g; __device__ __forceinline__ float operator()(int k, int n) const {
    const int t = n >> 8, j = n & 255; const int src = (j < 128) ? (128 * t + j) : (DFF + 128 * t + (j - 128)); return w[(size_t)k * (2 * DFF) + src] * g[k]; } };

__constant__ double ROPE_INV[16] = {1.0, 0.5623413251903491, 0.31622776601683794, 0.1778279410038923, 0.1, 0.05623413251903491, 0.03162277660168379, 0.01778279410038923,
                                    0.01, 0.005623413251903491, 0.0031622776601683794, 0.0017782794100389228, 0.001, 0.0005623413251903491, 0.00031622776601683794, 0.00017782794100389227};

__device__ __forceinline__ void rms_row_to_bf16(const float* xrow, const f32x4 (&g)[4], bf16_t* orow, int lane) {
    const f32x4* xr = (const f32x4*)xrow + lane;
    f32x4 v[4]; float s = 0.f;
#pragma unroll
    for (int j = 0; j < 4; ++j) { v[j] = xr[64 * j]; s += (v[j][0] * v[j][0] + v[j][1] * v[j][1]) + (v[j][2] * v[j][2] + v[j][3] * v[j][3]); }
    const float r = __builtin_amdgcn_rsqf(wave_sum(s) * (1.f / DM) + EPS);
    u32x2* o8 = (u32x2*)orow + lane;
#pragma unroll
    for (int j = 0; j < 4; ++j) { const f32x4 y = v[j] * g[j] * r; u32x2 w; w.x = cvt_pk_bf16(y[0], y[1]); w.y = cvt_pk_bf16(y[2], y[3]); o8[64 * j] = w; }
}

__device__ __forceinline__ void p0_prologue(Frame& F, const Args& AR) {
    unsigned char* ws = F.ws; unsigned char* dob = (unsigned char*)F.out;
    bf16_t* WzT = (bf16_t*)(ws + WS_WZT); bf16_t* WfT = (bf16_t*)(ws + WS_WFT); bf16_t* WxkT = (bf16_t*)(ws + WS_WXKT); bf16_t* WxvT = (bf16_t*)(ws + WS_WXVT);
    bf16_t* WuqT = (bf16_t*)(ws + WS_WUQT); bf16_t* WukvT = (bf16_t*)(ws + WS_WUKVT); bf16_t* DFTM = (bf16_t*)(ws + WS_DFTM); bf16_t* WoutT = (bf16_t*)(ws + WS_WOUTT);
    bf16_t* WxqT = (bf16_t*)(ws + WS_WXQT); bf16_t* WxoT = (bf16_t*)(ws + WS_WXOT); bf16_t* WguT = (bf16_t*)(ws + WS_WGUT); bf16_t* WdT = (bf16_t*)(ws + WS_WDT);
    float* ropeC = (float*)(ws + WS_ROPEC); float* ropeS = (float*)(ws + WS_ROPES);
    bf16_t* XN = (bf16_t*)(ws + WS_R0); bf16_t* MN = (bf16_t*)(dob + DO_MN);
    const int gw = F.vcu * NWAVES + F.wave, NGW = F.G * NWAVES, gt = F.vcu * 512 + F.tid, NGT = F.G * 512;
    for (int it = F.vcu; it < 256; it += F.G) {
        const int g = it >> 6, k0 = (it & 63) * 16; LAS float* Wl = (LAS float*)F.lds;
#pragma unroll
        for (int e = 0; e < 4; ++e) { const int idx = F.tid + 512 * e; Wl[idx] = AR.in[5][(size_t)(k0 + (idx >> 7)) * INW + 672 + g * 128 + (idx & 127)]; }
        LDS_WAIT(); __syncthreads();
        const int nl = F.tid & 255, cs = nl >> 7, j = nl & 127, kh = F.tid >> 8; float a[8];
#pragma unroll
        for (int e = 0; e < 8; ++e) a[e] = 0.f;
        for (int c = 0; c < 128; ++c) { const float ph = (float)((j * c) & 127) * (1.0f / 128.0f); const float tv = cs ? __builtin_amdgcn_sinf(ph) : __builtin_amdgcn_cosf(ph);
#pragma unroll
            for (int e = 0; e < 8; ++e) a[e] += Wl[(kh * 8 + e) * 128 + c] * tv; }
        u32x4 o; o.x = cvt_pk_bf16(a[0], a[1]); o.y = cvt_pk_bf16(a[2], a[3]); o.z = cvt_pk_bf16(a[4], a[5]); o.w = cvt_pk_bf16(a[6], a[7]);
        *(u32x4*)(WfT + (size_t)(cs * 512 + g * 128 + j) * 1024 + k0 + kh * 8) = o;
        __syncthreads();
    }
    for (int it = F.vcu; it < 128; it += F.G) {
        const int g = it >> 5, n0 = (it & 31) * 32; LAS float* Wf = (LAS float*)F.lds; LAS float* Wo = (LAS float*)(F.lds + 65536);
#pragma unroll 8
        for (int e = 0; e < 32; ++e) { const int idx = F.tid + 512 * e; Wf[idx] = AR.in[10][(size_t)g * 16384 + idx]; }
#pragma unroll
        for (int e = 0; e < 8; ++e) { const int idx = F.tid + 512 * e; Wo[idx] = AR.in[11][(size_t)(512 + g * 128 + (idx >> 5)) * DM + n0 + (idx & 31)]; }
        LDS_WAIT(); __syncthreads();
        const int n = F.tid & 31, grp = F.tid >> 5; float a[8];
#pragma unroll
        for (int e = 0; e < 8; ++e) a[e] = 0.f;
        for (int c = 0; c < 128; ++c) { const float wv = Wo[c * 32 + n];
#pragma unroll
            for (int e = 0; e < 8; ++e) a[e] += Wf[(grp * 8 + e) * 128 + c] * wv; }
        u32x4 o; o.x = cvt_pk_bf16(a[0], a[1]); o.y = cvt_pk_bf16(a[2], a[3]); o.z = cvt_pk_bf16(a[4], a[5]); o.w = cvt_pk_bf16(a[6], a[7]);
        *(u32x4*)(WoutT + (size_t)(n0 + n) * 1024 + 512 + g * 128 + grp * 8) = o;
        __syncthreads();
    }
    {
        LAS float* scr = (LAS float*)(F.lds + F.wave * 16384);
        constexpr int I_WZ = 16 * 24, I_XK = 16 * 32, I_XV = 16 * 32, I_UQ = 6 * 24, I_UKV = 4 * 32, I_OUT = 8 * 32, I_XQ = 16 * 32, I_XO = 16 * 32, I_GU = 16 * 176, I_D = 44 * 32;
        constexpr int NITEMS = I_WZ + I_XK + I_XV + I_UQ + I_UKV + I_OUT + I_XQ + I_XO + I_GU + I_D;
        for (int it = gw; it < NITEMS; it += NGW) {
            int r = it;
            if (r < I_WZ) { transpose_item(SrcWz{AR.in[5]}, r, 24, WzT, 1024, scr, F.lane); continue; } r -= I_WZ;
            if (r < I_XK) { transpose_item(SrcPlain{AR.in[15], 2048, 0}, r, 32, WxkT, 1024, scr, F.lane); continue; } r -= I_XK;
            if (r < I_XV) { transpose_item(SrcPlain{AR.in[15], 2048, 1024}, r, 32, WxvT, 1024, scr, F.lane); continue; } r -= I_XV;
            if (r < I_UQ) { transpose_item(SrcUq{AR.in[7], AR.in[6]}, r, 24, WuqT, QL, scr, F.lane); continue; } r -= I_UQ;
            if (r < I_UKV) { transpose_item(SrcGain{AR.in[9], AR.in[8], 1024, 1.f}, r, 32, WukvT, KVL, scr, F.lane); continue; } r -= I_UKV;
            if (r < I_OUT) { transpose_item(SrcPlain{AR.in[11], 1024, 0}, r, 32, WoutT, 1024, scr, F.lane); continue; } r -= I_OUT;
            if (r < I_XQ) { transpose_item(SrcGain{AR.in[14], AR.in[12], 1024, XSCALE}, r, 32, WxqT, 1024, scr, F.lane); continue; } r -= I_XQ;
            if (r < I_XO) { transpose_item(SrcPlain{AR.in[16], 1024, 0}, r, 32, WxoT, 1024, scr, F.lane); continue; } r -= I_XO;
            if (r < I_GU) { transpose_item(SrcGu{AR.in[18], AR.in[17]}, r, 176, WguT, 1024, scr, F.lane); continue; } r -= I_GU;
            transpose_item(SrcPlain{AR.in[19], 1024, 0}, r, 32, WdT, DFF, scr, F.lane);
        }
    }
    for (int ch = gt; ch < 2 * 1024 * 128; ch += NGT) { const int mat = ch >> 17, r = (ch >> 7) & 1023, c0 = (ch & 127) * 8; float v[8];
#pragma unroll
        for (int e = 0; e < 8; ++e) { const int cc = c0 + e, sx = cc & 511; const float ph = mat ? (float)(((2 * r + 1) * sx) & 2047) * (1.0f / 2048.0f) : (float)((r * sx) & 1023) * (1.0f / 1024.0f);
            v[e] = (cc < 512 ? __builtin_amdgcn_cosf(ph) : -__builtin_amdgcn_sinf(ph)) * (1.0f / 512.0f); }
        u32x4 o; o.x = cvt_pk_bf16(v[0], v[1]); o.y = cvt_pk_bf16(v[2], v[3]); o.z = cvt_pk_bf16(v[4], v[5]); o.w = cvt_pk_bf16(v[6], v[7]);
        *(u32x4*)(DFTM + (size_t)mat * (1024 * 1024) + (size_t)r * 1024 + c0) = o; }
    for (int idx = gt; idx < SEQ * 16; idx += NGT) { const int s = idx >> 4, i = idx & 15; const double rev = (double)s * ROPE_INV[i] * 0.15915494309189535; const float ph = (float)(rev - __builtin_floor(rev));
        ropeC[idx] = __builtin_amdgcn_cosf(ph); ropeS[idx] = __builtin_amdgcn_sinf(ph); }
    {
        bf16_t* XF = (bf16_t*)(ws + WS_XF); bf16_t* XL = (bf16_t*)(ws + WS_XL);
        f32x4 g[4];
#pragma unroll
        for (int j = 0; j < 4; ++j) g[j] = *((const f32x4*)AR.in[4] + F.lane + 64 * j);
        for (int task = gw; task < NB * 513; task += NGW) {
            const int b = task / 513, sx = task - b * 513; const int base = b * SEQ;
            const float* xb = (b < NBP) ? AR.in[0] + (size_t)base * DM : AR.in[1] + (size_t)(base - TP) * DM;
            if (sx == 0 || sx == 512) {
                f32x4 v[2][4];
#pragma unroll
                for (int q = 0; q < 2; ++q) { const int row = sx + q * 1024; const f32x4* xr = (const f32x4*)(xb + (size_t)row * DM) + F.lane; float ss = 0.f;
#pragma unroll
                    for (int j = 0; j < 4; ++j) { v[q][j] = xr[64 * j]; ss += (v[q][j][0] * v[q][j][0] + v[q][j][1] * v[q][j][1]) + (v[q][j][2] * v[q][j][2] + v[q][j][3] * v[q][j][3]); }
                    const float r = __builtin_amdgcn_rsqf(wave_sum(ss) * (1.f / DM) + EPS); u32x2* o8 = (u32x2*)(XN + (size_t)(base + row) * DM) + F.lane;
#pragma unroll
                    for (int j = 0; j < 4; ++j) { v[q][j] = v[q][j] * g[j] * r; u32x2 w; w.x = cvt_pk_bf16(v[q][j][0], v[q][j][1]); w.y = cvt_pk_bf16(v[q][j][2], v[q][j][3]); o8[64 * j] = w; } }
                u32x2* oA = (sx == 0) ? (u32x2*)(XF + (size_t)(base + 0 * 512) * DM) + F.lane : (u32x2*)(XL + (size_t)(0 * 256 + b) * DM) + F.lane;
                u32x2* oB = (sx == 0) ? (u32x2*)(XF + (size_t)(base + 2 * 512) * DM) + F.lane : (u32x2*)(XL + (size_t)(1 * 256 + b) * DM) + F.lane;
#pragma unroll
                for (int j = 0; j < 4; ++j) { const f32x4 sA = v[0][j] + v[1][j], sB = v[0][j] - v[1][j]; u32x2 w; w.x = cvt_pk_bf16(sA[0], sA[1]); w.y = cvt_pk_bf16(sA[2], sA[3]); oA[64 * j] = w;
                    w.x = cvt_pk_bf16(sB[0], sB[1]); w.y = cvt_pk_bf16(sB[2], sB[3]); oB[64 * j] = w; }
                if (sx == 0) { u32x2* z1 = (u32x2*)(XF + (size_t)(base + 1 * 512) * DM) + F.lane; u32x2* z3 = (u32x2*)(XF + (size_t)(base + 3 * 512) * DM) + F.lane; const u32x2 zz = {0u, 0u};
#pragma unroll
                    for (int j = 0; j < 4; ++j) { z1[64 * j] = zz; z3[64 * j] = zz; } }
            } else {
                f32x4 v[4][4];
#pragma unroll
                for (int q = 0; q < 4; ++q) { const int row = (q == 0) ? sx : (q == 1) ? sx + 1024 : (q == 2) ? 1024 - sx : 2048 - sx; const f32x4* xr = (const f32x4*)(xb + (size_t)row * DM) + F.lane; float ss = 0.f;
#pragma unroll
                    for (int j = 0; j < 4; ++j) { v[q][j] = xr[64 * j]; ss += (v[q][j][0] * v[q][j][0] + v[q][j][1] * v[q][j][1]) + (v[q][j][2] * v[q][j][2] + v[q][j][3] * v[q][j][3]); }
                    const float r = __builtin_amdgcn_rsqf(wave_sum(ss) * (1.f / DM) + EPS); u32x2* o8 = (u32x2*)(XN + (size_t)(base + row) * DM) + F.lane;
#pragma unroll
                    for (int j = 0; j < 4; ++j) { v[q][j] = v[q][j] * g[j] * r; u32x2 w; w.x = cvt_pk_bf16(v[q][j][0], v[q][j][1]); w.y = cvt_pk_bf16(v[q][j][2], v[q][j][3]); o8[64 * j] = w; } }
                u32x2* o0 = (u32x2*)(XF + (size_t)(base + 0 * 512 + sx) * DM) + F.lane; u32x2* o1 = (u32x2*)(XF + (size_t)(base + 1 * 512 + sx) * DM) + F.lane;
                u32x2* o2 = (u32x2*)(XF + (size_t)(base + 2 * 512 + sx) * DM) + F.lane; u32x2* o3 = (u32x2*)(XF + (size_t)(base + 3 * 512 + sx) * DM) + F.lane;
#pragma unroll
                for (int j = 0; j < 4; ++j) { const f32x4 ab = v[0][j] + v[1][j], cd = v[2][j] + v[3][j], amb = v[0][j] - v[1][j], cmd = v[2][j] - v[3][j];
                    const f32x4 ec = ab + cd, es = ab - cd, oc = amb - cmd, os = amb + cmd; u32x2 w;
                    w.x = cvt_pk_bf16(ec[0], ec[1]); w.y = cvt_pk_bf16(ec[2], ec[3]); o0[64 * j] = w;
                    w.x = cvt_pk_bf16(es[0], es[1]); w.y = cvt_pk_bf16(es[2], es[3]); o1[64 * j] = w;
                    w.x = cvt_pk_bf16(oc[0], oc[1]); w.y = cvt_pk_bf16(oc[2], oc[3]); o2[64 * j] = w;
                    w.x = cvt_pk_bf16(os[0], os[1]); w.y = cvt_pk_bf16(os[2], os[3]); o3[64 * j] = w; }
            }
        }
        for (int rr = gw; rr < 2 * 232; rr += NGW) { const int ty = rr / 232, row = 24 + rr % 232; u32x2* z = (u32x2*)(XL + (size_t)(ty * 256 + row) * DM) + F.lane; const u32x2 zz = {0u, 0u};
#pragma unroll
            for (int j = 0; j < 4; ++j) z[64 * j] = zz; }
#pragma unroll
        for (int j = 0; j < 4; ++j) g[j] = *((const f32x4*)AR.in[13] + F.lane + 64 * j);
        for (int m = gw; m < TMEM; m += NGW) rms_row_to_bf16(m < TMP ? AR.in[2] + (size_t)m * DM : AR.in[3] + (size_t)(m - TMP) * DM, g, MN + (size_t)m * DM, F.lane);
    }
}

__device__ __forceinline__ void final_norm(Frame& F, const Args& AR) {
    const float* PS = (const float*)(F.ws + WS_PS); const bf16_t* XB = (const bf16_t*)(F.ws + WS_R1);
    const int gw = F.vcu * NWAVES + F.wave, NGW = F.G * NWAVES;
    f32x4 g[4];
#pragma unroll
    for (int j = 0; j < 2; ++j) { g[2 * j] = *(const f32x4*)(AR.in[20] + j * 512 + 8 * F.lane); g[2 * j + 1] = *(const f32x4*)(AR.in[20] + j * 512 + 8 * F.lane + 4); }
    for (int m = gw; m < T; m += NGW) {
        const float pv = (F.lane < 16) ? PS[(size_t)m * 16 + F.lane] : 0.f;
        const float r = __builtin_amdgcn_rsqf(wave_sum(pv) * (1.f / DM) + EPS);
#pragma unroll
        for (int j = 0; j < 2; ++j) { const u32x4 w = *(const u32x4*)(XB + (size_t)m * DM + j * 512 + 8 * F.lane);
            const f32x4 y0 = (f32x4){__uint_as_float(w.x << 16), __uint_as_float(w.x & 0xffff0000u), __uint_as_float(w.y << 16), __uint_as_float(w.y & 0xffff0000u)};
            const f32x4 y1 = (f32x4){__uint_as_float(w.z << 16), __uint_as_float(w.z & 0xffff0000u), __uint_as_float(w.w << 16), __uint_as_float(w.w & 0xffff0000u)};
            float* o = F.out + (size_t)m * DM + j * 512 + 8 * F.lane;
            *(f32x4*)o = y0 * g[2 * j] * r; *(f32x4*)(o + 4) = y1 * g[2 * j + 1] * r; }
    }
}

constexpr int NSTEPS = 12;
__global__ void __launch_bounds__(NWAVES * 64, 2) fwd_kernel(Args args) {
    extern __shared__ __attribute__((aligned(16))) unsigned char lds_raw[];
    Frame F;
    F.lds = (LAS unsigned char*)lds_raw;
    F.tid = threadIdx.x; F.lane = F.tid & 63; F.wave = __builtin_amdgcn_readfirstlane(F.tid >> 6);
    F.G = GRID; { const int bx = blockIdx.x; F.vcu = (bx % 8) * (GRID / 8) + bx / 8; }
    F.out = args.out; F.ws = args.ws;
    volatile LAS unsigned* MISC = (volatile LAS unsigned*)(F.lds + MISC_OFF);
    if (F.tid < 32) MISC[F.tid] = 0u;
    __syncthreads();
    unsigned* ctl = (unsigned*)(F.ws + WS_CTL);
    XcdBarrier bar; bar.bar = ctl + CW_BAR; bar.x = 0; bar.st = nullptr;
    const int lo = args.st_lo, hi = args.st_hi;
    if (hi - lo > 1) bar = xcd_barrier_post(ctl + CW_BAR, MISC + 8);
#ifndef PH_MASK
#define PH_MASK 0xfff
#endif
#define IN(k) (((PH_MASK >> (k)) & 1) && lo <= (k) && (k) < hi)
#define SEAM(k) do { if (IN(k) && IN((k) + 1)) xcd_barrier(bar); } while (0)
#define MIB(x) ((int)((x) / MiB))
#ifndef REPEAT_PH
#define REPEAT_PH -1
#endif
#define TWICE(k, ...) do { __VA_ARGS__ if (REPEAT_PH == (k)) { xcd_barrier(bar); __VA_ARGS__ } } while (0)
    unsigned char* ws = F.ws; unsigned char* dob = (unsigned char*)F.out;
    Epi E; E.ws = ws; E.out = F.out; E.xp = nullptr; E.xs = nullptr;
    if (IN(0)) TWICE(0, { p0_prologue(F, args); }); SEAM(0);
    if (IN(1)) TWICE(1, { Sched<SK_P1, 0, 1024, 1024> S{(const char*)ws, (const char*)dob}; gemm_phase<SK_P1, 0, 1024, 1024, 1024, EK_P1, 0>(F.lds, S, E); }); SEAM(1);
    if (IN(2)) TWICE(2, {
        { Sched<SK_GEN, 3, ZW, QL> S{(const char*)(dob + DO_Z), (const char*)(ws + WS_WUQT)}; gemm_phase<SK_GEN, 3, ZW, QL, QL, EK_Q, 0>(F.lds, S, E); }
        { Sched<SK_GEN, 4, ZW, KVL> S{(const char*)(dob + DO_Z) + QL * 2, (const char*)(ws + WS_WUKVT)}; gemm_phase<SK_GEN, 4, ZW, KVL, KVL, EK_KV, 0>(F.lds, S, E); }
    }); SEAM(2);
    if (IN(3)) {
        TWICE(30, { Sched<SK_DFT, 0, 1024, 1024> S{(const char*)(ws + WS_DFTM), (const char*)(ws + WS_R1)}; gemm_phase<SK_DFT, 0, 1024, 1024, 1024, EK_DFT, MIB(WS_R0)>(F.lds, S, E); });
        const int c = (int)blockIdx.x, x = c & 7, j = c >> 3;
        const int nun = 6;
        const bf16_t* Qb = (const bf16_t*)(dob + DO_Q); const bf16_t* Kfb = (const bf16_t*)(ws + WS_KF); const bf16_t* Vb = (const bf16_t*)(ws + WS_V); bf16_t* Y = (bf16_t*)(ws + WS_R0);
        TWICE(31, {for (int r = 0; r < nun; ++r) {
            const int uidx = j + 32 * r;
            const int bh = x * 24 + (uidx >> 3), qb = uidx & 7, b = bh >> 3, h = bh & 7;
            const size_t row0 = (size_t)b * SEQ;
            mla::attn_unit(Qb + (row0 + qb * 256) * 768 + h * DQK, Kfb + row0 * 768 + h * DQK, Vb + row0 * 512 + h * DVH, Y + (row0 + qb * 256) * 1024 + h * DVH, (char*)lds_raw);
        } });
    } SEAM(3);
    if (IN(4)) TWICE(4, { Epi E4 = E; E4.xp = args.in[0]; E4.xs = args.in[1];
        Sched<SK_GEN, 4, 1024, 1024> S{(const char*)(ws + WS_R0), (const char*)(ws + WS_WOUTT)}; gemm_phase<SK_GEN, 4, 1024, 1024, 1024, EK_RES_X, MIB(WS_R1)>(F.lds, S, E4); }); SEAM(4);
    if (IN(5)) TWICE(5, { Sched<SK_GEN, 4, 1024, 1024> S{(const char*)(ws + WS_R1), (const char*)(ws + WS_WXQT)}; gemm_phase<SK_GEN, 4, 1024, 1024, 1024, EK_ROWSCALE, MIB(WS_R0)>(F.lds, S, E); }); SEAM(5);
    if (IN(6)) TWICE(6, { Sched<SK_XS, 4, 1024, 1024> S{(const char*)(ws + WS_R0), (const char*)(ws + WS_KX)}; gemm_phase<SK_XS, 4, 1024, 1024, 256, EK_SOFTMAX, MIB(WS_R2)>(F.lds, S, E); }); SEAM(6);
    if (IN(7)) TWICE(7, { Sched<SK_XPV, 4, 1024, 256> S{(const char*)(ws + WS_R2), (const char*)(ws + WS_VXT)}; gemm_phase<SK_XPV, 4, 1024, 256, 256, EK_PLAIN, MIB(WS_R0)>(F.lds, S, E); }); SEAM(7);
    if (IN(8)) { Sched<SK_GEN, 4, 1024, 1024> S{(const char*)(ws + WS_R0), (const char*)(ws + WS_WXOT)}; gemm_phase<SK_GEN, 4, 1024, 1024, 1024, EK_RES, MIB(WS_R1)>(F.lds, S, E); } SEAM(8);
#ifdef SHADOW9
    if (IN(9)) { Sched<SK_GEN, 22, 1024, 1024> S{(const char*)(ws + WS_R1), (const char*)(ws + WS_WGUT)}; gemm_phase<SK_GEN, 22, 1024, 1024, 1024, SHADOW9, MIB(WS_H)>(F.lds, S, E); xcd_barrier(bar); }
#endif
    if (IN(9)) TWICE(9, { Sched<SK_GEN, 22, 1024, 1024> S{(const char*)(ws + WS_R1), (const char*)(ws + WS_WGUT)}; gemm_phase<SK_GEN, 22, 1024, 1024, 1024, EK_SWIGLU, MIB(WS_H)>(F.lds, S, E); }); SEAM(9);
    if (IN(10)) { Sched<SK_GEN, 4, DFF, DFF> S{(const char*)(ws + WS_H), (const char*)(ws + WS_WDT)}; gemm_phase<SK_GEN, 4, DFF, DFF, DFF, EK_RES_NOB, 0>(F.lds, S, E); } SEAM(10);
    if (IN(11)) { final_norm(F, args); }
#undef IN
#undef SEAM
#undef MIB
}

extern "C" void kernel_launch(void* const* d_in, const int* in_sizes, int n_in, void* d_out, int out_size, void* d_ws, size_t ws_size, hipStream_t stream) {
    static int grid = 0;
    if (grid == 0) {
        if (n_in != 21 || in_sizes[0] != TP * DM || in_sizes[1] != (T - TP) * DM || out_size != T * DM || ws_size < WS_END) {
            fprintf(stderr, "kernel_launch: unexpected shapes (n_in %d, in0 %d, out %d, ws %zu); nothing launched\n", n_in, n_in > 0 ? in_sizes[0] : -1, out_size, ws_size); grid = -1; return; }
        int dev = 0, cus = 0, per_cu = 0;
        if (hipGetDevice(&dev) != hipSuccess || hipDeviceGetAttribute(&cus, hipDeviceAttributeMultiprocessorCount, dev) != hipSuccess) { grid = -1; return; }
        if (hipFuncSetAttribute((const void*)fwd_kernel, hipFuncAttributeMaxDynamicSharedMemorySize, LDS_BYTES) != hipSuccess) { fprintf(stderr, "kernel_launch: hipFuncSetAttribute failed\n"); grid = -1; return; }
        if (hipOccupancyMaxActiveBlocksPerMultiprocessor(&per_cu, (const void*)fwd_kernel, NWAVES * 64, LDS_BYTES) != hipSuccess || per_cu < 1) { fprintf(stderr, "kernel_launch: occupancy query says %d blocks/CU\n", per_cu); grid = -1; (void)hipGetLastError(); return; }
        (void)hipGetLastError();
        if (cus != 256) { fprintf(stderr, "kernel_launch: built for 256 CUs, device has %d\n", cus); grid = -1; return; }
        grid = cus;
    }
    if (grid < 0) return;
    (void)hipMemsetAsync((char*)d_ws + WS_CTL, 0, CTL_ZERO_BYTES, stream);
    Args a{};
    for (int i = 0; i < 21; ++i) a.in[i] = (const float*)d_in[i];
    a.out = (float*)d_out; a.ws = (unsigned char*)d_ws;
#if DBG_STEPS
    for (int st = 0; st < NSTEPS; ++st) { a.st_lo = st; a.st_hi = st + 1; hipLaunchKernelGGL(fwd_kernel, dim3(grid), dim3(NWAVES * 64), LDS_BYTES, stream, a); }
#else
    a.st_lo = 0; a.st_hi = NSTEPS;
    hipLaunchKernelGGL(fwd_kernel, dim3(grid), dim3(NWAVES * 64), LDS_BYTES, stream, a);
#endif
}
```
